# Optimizing an MI355X kernel written in HIP

```python
import jax, jax.numpy as jnp
from jax import lax
import numpy as np

D_MODEL = 1024
BATCH = 8
SEQ = 4096
DEPTH = 4

PLE_DIM = 256
N_BRANCHES = 3
POOL_WINDOWS = (2, 4, 8, 16)
POOL_GROUPS = 4
POOL_WIDTH = D_MODEL
POOL_GROUP_DIM = POOL_WIDTH // POOL_GROUPS
ATTN_GROUPS = ((128, 1), (512, 4), (2048, 16))
ATTN_HEADS_PER_GROUP = 4
ATTN_HEADS = ATTN_HEADS_PER_GROUP * len(ATTN_GROUPS)
ATTN_HEAD_DIM = 128
ATTN_WIDTH = ATTN_HEADS * ATTN_HEAD_DIM
ATTN_OUT_WIDTH = ATTN_HEADS_PER_GROUP * ATTN_HEAD_DIM
ALIBI_MAX_BIAS = 8.0
NEG_INF = -1e30
HGRN_HEADS = 8
HGRN_HEAD_DIM = 128
HGRN_WIDTH = HGRN_HEADS * HGRN_HEAD_DIM
HGRN_CHUNK = 32
FFN_HIDDEN = ((8 * D_MODEL + 3 * 256 - 1) // (3 * 256)) * 256
IN_SIZES = (POOL_WIDTH, ATTN_WIDTH, ATTN_WIDTH, ATTN_WIDTH,
            HGRN_WIDTH, HGRN_WIDTH, HGRN_WIDTH, HGRN_WIDTH, HGRN_WIDTH,
            N_BRANCHES * D_MODEL)
IN_WIDTH = sum(IN_SIZES)
DEEPNORM_ALPHA = (2 * DEPTH) ** 0.25
DEEPNORM_BETA = (8 * DEPTH) ** -0.25
LN_EPS = 1e-5
RMS_EPS = 1e-6

kernel_name = "hybrid_pool_dilattn_hgrn2_encoder"


def layer_norm(x, g, b):
    xf = x.astype(jnp.float32)
    mu = jnp.mean(xf, axis=-1, keepdims=True)
    var = jnp.mean(jnp.square(xf - mu), axis=-1, keepdims=True)
    y = (xf - mu) * lax.rsqrt(var + LN_EPS)
    return (y * g.astype(jnp.float32) + b.astype(jnp.float32)).astype(x.dtype)


def multiscale_pool(a, pool_w, pool_scale):
    B, S, _ = a.shape
    af = a.astype(jnp.float32).reshape(B, S, POOL_GROUPS, POOL_GROUP_DIM)
    csum = jnp.concatenate([jnp.zeros_like(af[:, :1]), jnp.cumsum(af, axis=1)], axis=1)
    pos = jnp.arange(S, dtype=jnp.int32)[:, None]
    half = jnp.asarray(POOL_WINDOWS, jnp.int32)[None, :] // 2
    lo = jnp.clip(pos - half, 0, S)
    hi = jnp.clip(pos + half, 0, S)
    grp = jnp.arange(POOL_GROUPS, dtype=jnp.int32)[None, :]
    wsum = csum[:, hi, grp] - csum[:, lo, grp]
    count = (hi - lo).astype(jnp.float32)[None, :, :, None]
    mixed = wsum / count - af
    y = jnp.einsum('bsgc,gcd->bsgd', mixed, pool_w.astype(jnp.float32))
    return (y.reshape(B, S, POOL_WIDTH) * pool_scale.astype(jnp.float32)).astype(a.dtype)


def dilated_band_attention(q, k, v, dilation, side, slopes):
    B, S, H, Dh = q.shape
    L = S // dilation
    nb = -(-L // side)
    Lp = nb * side

    def to_sub(t):
        return t.astype(jnp.float32).reshape(B, L, dilation, H, Dh).transpose(0, 2, 3, 1, 4)

    qs = jnp.pad(to_sub(q), ((0, 0), (0, 0), (0, 0), (0, Lp - L), (0, 0)))
    kv_pad = ((0, 0), (0, 0), (0, 0), (side, Lp - L + side), (0, 0))
    ks = jnp.pad(to_sub(k), kv_pad)
    vs = jnp.pad(to_sub(v), kv_pad)
    qb = qs.reshape(B, dilation, H, nb, side, Dh)

    def windows(t):
        tb = t.reshape(B, dilation, H, nb + 2, side, Dh)
        return jnp.concatenate([tb[:, :, :, :-2], tb[:, :, :, 1:-1], tb[:, :, :, 2:]], axis=4)

    kw, vw = windows(ks), windows(vs)
    scores = jnp.einsum('brhnqe,brhnke->brhnqk', qb, kw) * (Dh ** -0.5)
    r = jnp.arange(side, dtype=jnp.int32)[:, None]
    c = jnp.arange(3 * side, dtype=jnp.int32)[None, :]
    off = c - side - r
    kj = jnp.arange(nb, dtype=jnp.int32)[:, None, None] * side - side + c[None]
    valid = (jnp.abs(off)[None] <= side) & (kj >= 0) & (kj < L)
    dist = (jnp.abs(off) * dilation).astype(jnp.float32)
    bias = -slopes.astype(jnp.float32)[:, None, None, None] * dist[None, None]
    scores = jnp.where(valid, scores + bias, NEG_INF)
    lse = jax.nn.logsumexp(scores, axis=-1)
    probs = jnp.exp(scores - lse[..., None])
    o = jnp.einsum('brhnqk,brhnke->brhnqe', probs, vw)
    o = o.reshape(B, dilation, H, Lp, Dh)[:, :, :, :L].transpose(0, 3, 1, 2, 4).reshape(B, S, H, Dh)
    lse = lse.reshape(B, dilation, H, Lp)[..., :L].transpose(0, 3, 1, 2).reshape(B, S, H)
    return o, lse


def dilated_attention_mixer(q_raw, k_raw, v_raw):
    B, S, _ = q_raw.shape
    shp = (B, S, ATTN_HEADS, ATTN_HEAD_DIM)
    q, k, v = q_raw.reshape(shp), k_raw.reshape(shp), v_raw.reshape(shp)
    slopes = 2.0 ** (-ALIBI_MAX_BIAS * jnp.arange(1, ATTN_HEADS + 1, dtype=jnp.float32) / ATTN_HEADS)
    outs, lses = [], []
    for g, (window, dilation) in enumerate(ATTN_GROUPS):
        sl = slice(g * ATTN_HEADS_PER_GROUP, (g + 1) * ATTN_HEADS_PER_GROUP)
        o, l = dilated_band_attention(q[:, :, sl], k[:, :, sl], v[:, :, sl],
                                      dilation, window // (2 * dilation), slopes[sl])
        outs.append(o)
        lses.append(l)
    w = jax.nn.softmax(jnp.stack(lses, axis=0), axis=0)
    o = jnp.sum(w[..., None] * jnp.stack(outs, axis=0), axis=0)
    return o.reshape(B, S, ATTN_OUT_WIDTH).astype(q_raw.dtype)


def hgrn2_scan(q, k, v, log_f):
    B, S, H, Dk = q.shape
    Dv = v.shape[-1]
    C = HGRN_CHUNK
    N = S // C

    def chunks(t):
        return t.reshape(B, N, C, H, t.shape[-1]).transpose(1, 0, 3, 2, 4)

    qc, kc, vc, fc = chunks(q), chunks(k), chunks(v), chunks(log_f)
    b = jnp.cumsum(fc, axis=3)
    b_end = b[:, :, :, -1:]
    qe = qc * jnp.exp(b)
    kd = kc * jnp.exp(b_end - b)
    att = jnp.einsum('nbhte,nbhse->nbhts', qe, kc * jnp.exp(-b))
    lower = jnp.tril(jnp.ones((C, C), dtype=bool))
    o_intra = jnp.einsum('nbhts,nbhsv->nbhtv', jnp.where(lower, att, 0.0), vc)
    decay = jnp.exp(b_end[:, :, :, 0])

    def step(state, xs):
        qe_n, kd_n, v_n, decay_n = xs
        o_n = jnp.einsum('bhte,bhev->bhtv', qe_n, state)
        state = decay_n[..., None] * state + jnp.einsum('bhse,bhsv->bhev', kd_n, v_n)
        return state, o_n

    init = jnp.zeros((B, H, Dk, Dv), jnp.float32)
    _, o_inter = lax.scan(step, init, (qe, kd, vc, decay))
    o = o_intra + o_inter
    return o.transpose(1, 0, 3, 2, 4).reshape(B, S, H, Dv)


def hgrn2_bidirectional(q_raw, i_raw, f_fwd_raw, f_bwd_raw, g_raw, lb_fwd, lb_bwd, norm_w):
    B, S, _ = q_raw.shape

    def heads(t):
        return t.astype(jnp.float32).reshape(B, S, HGRN_HEADS, HGRN_HEAD_DIM)

    q = jax.nn.silu(heads(q_raw))
    v = heads(i_raw)

    def forget(raw, lb):
        lb = lb.reshape(HGRN_HEADS, HGRN_HEAD_DIM)
        z = heads(raw)
        f = lb + (1.0 - lb) * jax.nn.sigmoid(z)
        return (1.0 - lb) * jax.nn.sigmoid(-z), jnp.log(f)

    k_f, logf_f = forget(f_fwd_raw, lb_fwd)
    k_b, logf_b = forget(f_bwd_raw, lb_bwd)
    flip = lambda t: jnp.flip(t, axis=1)
    o = hgrn2_scan(q, k_f, v, logf_f) + flip(hgrn2_scan(flip(q), flip(k_b), flip(v), flip(logf_b)))
    o = o * lax.rsqrt(jnp.mean(jnp.square(o), axis=-1, keepdims=True) + RMS_EPS)
    o = o * norm_w.astype(jnp.float32).reshape(HGRN_HEADS, HGRN_HEAD_DIM) * jax.nn.silu(heads(g_raw))
    return o.reshape(B, S, HGRN_WIDTH).astype(q_raw.dtype)


def setup_inputs(seed: int = 0) -> dict:
    key = jax.random.key(seed)
    ks = jax.random.split(key, 20)
    f32 = jnp.float32

    def dense(k, shape, fan_in, scale=1.0):
        return jax.random.normal(k, shape, f32) * (scale * fan_in ** -0.5)

    def gain(k, shape):
        return 1.0 + 0.02 * jax.random.normal(k, shape, f32)

    def small(k, shape):
        return 0.02 * jax.random.normal(k, shape, f32)

    return {
        "x": jax.random.normal(ks[0], (BATCH, SEQ, D_MODEL), f32),
        "p": jax.random.normal(ks[1], (DEPTH, BATCH, SEQ, PLE_DIM), f32),
        "w_in": dense(ks[2], (DEPTH, D_MODEL, IN_WIDTH), D_MODEL),
        "pool_w": dense(ks[3], (DEPTH, POOL_GROUPS, POOL_GROUP_DIM, POOL_GROUP_DIM), POOL_GROUP_DIM),
        "pool_scale": gain(ks[4], (DEPTH, POOL_WIDTH)),
        "w_branch_a": dense(ks[5], (DEPTH, POOL_WIDTH, D_MODEL), POOL_WIDTH),
        "w_branch_b": dense(ks[6], (DEPTH, ATTN_OUT_WIDTH, D_MODEL), ATTN_OUT_WIDTH),
        "w_branch_c": dense(ks[7], (DEPTH, HGRN_WIDTH, D_MODEL), HGRN_WIDTH),
        "hgrn_lb_logits": 0.5 * jax.random.normal(ks[8], (DEPTH, 2 * HGRN_WIDTH), f32),
        "hgrn_norm_w": gain(ks[9], (DEPTH, HGRN_WIDTH)),
        "w_out": dense(ks[10], (DEPTH, D_MODEL, D_MODEL), D_MODEL, DEEPNORM_BETA),
        "ln1_g": gain(ks[11], (DEPTH, D_MODEL)),
        "ln1_b": small(ks[12], (DEPTH, D_MODEL)),
        "w_ffn_gate": dense(ks[13], (DEPTH, D_MODEL, FFN_HIDDEN), D_MODEL),
        "w_ffn_up": dense(ks[14], (DEPTH, D_MODEL, FFN_HIDDEN), D_MODEL),
        "w_ffn_down": dense(ks[15], (DEPTH, FFN_HIDDEN, D_MODEL), FFN_HIDDEN, DEEPNORM_BETA),
        "w_ple_proj": dense(ks[16], (DEPTH, PLE_DIM, D_MODEL), PLE_DIM, DEEPNORM_BETA),
        "w_ple_gate": dense(ks[17], (DEPTH, D_MODEL, D_MODEL), D_MODEL),
        "ln2_g": gain(ks[18], (DEPTH, D_MODEL)),
        "ln2_b": small(ks[19], (DEPTH, D_MODEL)),
    }


def reference(x, p, w_in, pool_w, pool_scale, w_branch_a, w_branch_b, w_branch_c,
              hgrn_lb_logits, hgrn_norm_w, w_out, ln1_g, ln1_b, w_ffn_gate, w_ffn_up,
              w_ffn_down, w_ple_proj, w_ple_gate, ln2_g, ln2_b):
    B, S, _ = x.shape
    lb = jnp.cumsum(jax.nn.softmax(hgrn_lb_logits.astype(jnp.float32), axis=0), axis=0)
    lb = lb - lb[:1]
    splits = np.cumsum(IN_SIZES)[:-1].tolist()
    for i in range(DEPTH):
        proj = jnp.einsum('bsd,de->bse', x, w_in[i])
        (a_in, q_att, k_att, v_att, q_h, i_h, ff_h, fb_h, g_h, gate_raw) = jnp.split(proj, splits, axis=-1)
        y_a = jnp.einsum('bsc,cd->bsd', multiscale_pool(a_in, pool_w[i], pool_scale[i]), w_branch_a[i])
        y_b = jnp.einsum('bsc,cd->bsd', dilated_attention_mixer(q_att, k_att, v_att), w_branch_b[i])
        y_c = jnp.einsum('bsc,cd->bsd',
                         hgrn2_bidirectional(q_h, i_h, ff_h, fb_h, g_h,
                                             lb[i, :HGRN_WIDTH], lb[i, HGRN_WIDTH:], hgrn_norm_w[i]),
                         w_branch_c[i])
        gates = jax.nn.sigmoid(gate_raw.astype(jnp.float32)).reshape(B, S, N_BRANCHES, D_MODEL)
        merged = (gates[:, :, 0] * y_a + gates[:, :, 1] * y_b + gates[:, :, 2] * y_c).astype(x.dtype)
        mix = jnp.einsum('bsd,de->bse', merged, w_out[i])
        x1 = layer_norm(DEEPNORM_ALPHA * x + mix, ln1_g[i], ln1_b[i])
        hidden = jax.nn.silu(jnp.einsum('bsd,df->bsf', x1, w_ffn_gate[i])) * jnp.einsum('bsd,df->bsf', x1, w_ffn_up[i])
        ffn = jnp.einsum('bsf,fd->bsd', hidden, w_ffn_down[i])
        ple = jnp.einsum('bsc,cd->bsd', p[i], w_ple_proj[i]) * jax.nn.sigmoid(jnp.einsum('bsd,de->bse', x1, w_ple_gate[i]))
        x = layer_norm(DEEPNORM_ALPHA * x1 + ffn + ple, ln2_g[i], ln2_b[i])
    return x
```

```cpp
#include <hip/hip_runtime.h>
#include <hip/hip_cooperative_groups.h>
#include <cstdio>
#include <cstdint>
namespace cg = cooperative_groups;

#ifndef MK_MULTI
#define MK_MULTI 0
#endif

#ifndef DBG_NPH
#define DBG_NPH 0
#endif
#ifndef DBG_OFF
#define DBG_OFF 0
#endif
constexpr int DM = 1024, NBATCH = 8, SEQ = 4096, DEPTH = 4, T = NBATCH * SEQ;
constexpr int PLE = 256, FFH = 2816, INW = 13824;
constexpr int NCH = 4, TC = T / NCH;
constexpr int C_POOL = 0, C_AQ = 1024, C_AK = 2560, C_AV = 4096, C_HQ = 5632, C_HI = 6656, C_HFF = 7680, C_HFB = 8704, C_HG = 9728, C_GATE = 10752;
constexpr int PJW = 10752;
constexpr int MCW = 2560;
constexpr int HDW = 3072;
constexpr float ALPHA = 1.681792830507429f;
constexpr float LN_EPS = 1e-5f, RMS_EPS = 1e-6f;

constexpr size_t MiB = 1u << 20;
constexpr size_t WS_LB = 0, WS_BAR = 512 * 1024;
constexpr size_t WS_WIN = 1 * MiB, WS_WCAT = 28 * MiB, WS_WOUT = 33 * MiB, WS_WGU = 35 * MiB, WS_WDP = 48 * MiB;
constexpr size_t WS_XBF = 54 * MiB, WS_MIXCAT = 118 * MiB, WS_GATES = 278 * MiB, WS_PROJC = 470 * MiB, WS_LOGF = 638 * MiB, WS_OHG = 702 * MiB, WS_ATTO = 798 * MiB, WS_LSE = 822 * MiB, WS_VF = 823 * MiB, WS_DC = 839 * MiB, WS_OIF1 = 843 * MiB, WS_END = 859 * MiB;
constexpr size_t WS_QF = 734 * MiB, WS_KF = 766 * MiB;
constexpr size_t WS_MERGED = WS_PROJC, WS_HIDDEN = WS_MIXCAT, WS_PG = 734 * MiB;
constexpr int LDS_BYTES = 147456;

typedef unsigned short bf16_t;
typedef short bf16x8 __attribute__((ext_vector_type(8)));
typedef float f32x4 __attribute__((ext_vector_type(4)));
typedef float f32x2 __attribute__((ext_vector_type(2)));
typedef unsigned u32x4 __attribute__((ext_vector_type(4)));
typedef unsigned u32x2 __attribute__((ext_vector_type(2)));
#define LAS __attribute__((address_space(3)))
#define DI __device__ __forceinline__

typedef __bf16 bf16x2_t __attribute__((ext_vector_type(2)));
DI unsigned cvt_pk_bf16(float lo, float hi) { f32x2 v = {lo, hi}; bf16x2_t b = __builtin_convertvector(v, bf16x2_t); return __builtin_bit_cast(unsigned, b); }
DI float bf_lo(unsigned u) { return __uint_as_float(u << 16); }
DI float bf_hi(unsigned u) { return __uint_as_float(u & 0xffff0000u); }
DI float bf1(bf16_t u) { return __uint_as_float(((unsigned)u) << 16); }
DI float sigmoidf_(float x) { return __builtin_amdgcn_rcpf(1.f + __expf(-x)); }
DI float siluf_(float x) { return x * sigmoidf_(x); }
#define SHX(v, k) __int_as_float(__builtin_amdgcn_ds_swizzle(__float_as_int(v), 0x1f | ((k) << 10)))
DI float sh32(float v, int lane) { return __int_as_float(__builtin_amdgcn_ds_bpermute((lane ^ 32) << 2, __float_as_int(v))); }
DI float wave_sum(float v, int lane) { v += SHX(v, 1); v += SHX(v, 2); v += SHX(v, 4); v += SHX(v, 8); v += SHX(v, 16); v += sh32(v, lane); return v; }

namespace pg8 {
constexpr int BM = 256, BK = 64, HALF = 128, HTB = HALF * BK * 2, STAGE_BYTES = 8 * HTB, NXCD = 8, WGM = 8;
__host__ __device__ __forceinline__ int lds_byte(int r, int c) { const int st = (r >> 4) * 2 + (c >> 5), rr = r & 15, cc = c & 31, ob = rr * 64 + cc * 2; return st * 1024 + (ob ^ (((ob >> 9) & 1) << 5)); }
__host__ __device__ __forceinline__ void stage_rc(int b, int& R, int& C) { const int st = b / 1024, sb = b % 1024, swz = sb ^ (((sb >> 9) & 1) << 5); R = (st >> 1) * 16 + swz / 64; C = (st & 1) * 32 + (swz % 64) / 2; }
__host__ __device__ __forceinline__ int perm32(int rho) { const int n = rho >> 4, i = rho & 15; return 8 * (i >> 2) + 4 * n + (i & 3); }

struct Unit { int pm, pn, koff, nt, seg; };
struct Gemm { const bf16_t* A; const bf16_t* Bt; int lda, ldb; };

struct TileOrder {
    int nM, nN, nwg, G, c;
    DI void init(int nM_, int nN_, int G_, int c_) { nM = nM_; nN = nN_; nwg = nM * nN; G = G_; c = c_; }
    DI bool tile(int i, int& pm, int& pn) const {
        const long L = (long)i * G + c; if (L >= nwg) return false;
        int wgid = (int)L; { const int q = nwg / NXCD, r = nwg % NXCD, xcd = wgid % NXCD, off = wgid / NXCD; wgid = (xcd < r ? xcd * (q + 1) : r * (q + 1) + (xcd - r) * q) + off; }
        const int nig = WGM * nN, gid = wgid / nig, fm = gid * WGM, gsz = (nM - fm) < WGM ? (nM - fm) : WGM;
        pm = fm + ((wgid % nig) % gsz); pn = (wgid % nig) / gsz; return true;
    }
};
template <int NSEG, int K0, int K1, int K2, int N0, int N1, int N2>
struct SegSched {
    TileOrder o;
    DI bool next(int i, Unit& u) const {
        const int round = i / NSEG, s = i - round * NSEG;
        if (!o.tile(round, u.pm, u.pn)) return false;
        u.seg = s; u.koff = (s == 0) ? K0 : (s == 1 ? K1 : K2); u.nt = (s == 0) ? N0 : (s == 1 ? N1 : N2); return true;
    }
};

template <class Epi, class Sched>
DI void gemm_phase(LAS unsigned char* lds, const int tid, const float fz, const Gemm g, const Sched S, const Epi E) {
    const int wid = __builtin_amdgcn_readfirstlane(tid >> 6), lane = tid & 63, wr = wid >> 2, wc = wid & 3, fr = lane & 15, fq = lane >> 4;
    unsigned voffA[2], voffB[2];
#pragma unroll
    for (int i = 0; i < 2; ++i) { int R, C; stage_rc(tid * 16 + i * 8192, R, C); const int Rb = Epi::PERM ? ((R & ~31) + perm32(R & 31)) : R;
        voffA[i] = (unsigned)(R * g.lda + C) * 2u; voffB[i] = (unsigned)(Rb * g.ldb + C) * 2u; }
    const size_t kstep = (size_t)(BK * 2);
    const size_t hstepA = (size_t)HALF * g.lda * 2, hstepB = (size_t)HALF * g.ldb * 2;
    const size_t tstepA = 2 * hstepA, tstepB = 2 * hstepB;
    const unsigned ldsw = (unsigned)wid * 1024u;
    const int aoff = lds_byte(wr * 64 + fr, fq * 8), boff = lds_byte(wc * 32 + fr, fq * 8);
#define PG8_SA(b, h) (((b) * 2 + (h)) * HTB)
#define PG8_SB(b, h) ((4 + (b) * 2 + (h)) * HTB)
#define PG8_STAGE(bufoff, gbase, voff) do { _Pragma("unroll") for (int _i = 0; _i < 2; ++_i) \
        __builtin_amdgcn_global_load_lds((const unsigned*)((const char*)(gbase) + (voff)[_i]), (LAS unsigned*)(lds + (bufoff) + ldsw + _i * 8192), 16, 0, 0); } while (0)
#define PG8_LDA(dst, b, h) do { _Pragma("unroll") for (int m = 0; m < 4; ++m) _Pragma("unroll") for (int k = 0; k < 2; ++k) dst[m][k] = *(const LAS bf16x8*)(lds + PG8_SA(b, h) + aoff + m * 2048 + k * 1024); } while (0)
#define PG8_LDB(dst, b, h) do { _Pragma("unroll") for (int n = 0; n < 2; ++n) _Pragma("unroll") for (int k = 0; k < 2; ++k) dst[n][k] = *(const LAS bf16x8*)(lds + PG8_SB(b, h) + boff + n * 2048 + k * 1024); } while (0)
#define PG8_MMA(ai, bj, At, Bt) do { __builtin_amdgcn_s_setprio(1); _Pragma("unroll") for (int m = 0; m < 4; ++m) _Pragma("unroll") for (int n = 0; n < 2; ++n) _Pragma("unroll") for (int k = 0; k < 2; ++k) \
        acc[ai][bj][m][n] = __builtin_amdgcn_mfma_f32_16x16x32_bf16(Bt[n][k], At[m][k], acc[ai][bj][m][n], 0, 0, 0); __builtin_amdgcn_s_setprio(0); } while (0)
#define PG8_WAIT_V(n) asm volatile("s_waitcnt vmcnt(" #n ")" ::: "memory")
#define PG8_WAIT_L(n) asm volatile("s_waitcnt lgkmcnt(" #n ")" ::: "memory")
#define PG8_BAR __builtin_amdgcn_s_barrier()
#define PG8_SCHED __builtin_amdgcn_sched_barrier(0)
    Unit cur, nxt; int ui = 0;
    asm volatile("s_waitcnt vmcnt(0)" ::: "memory");
    if (!S.next(0, cur)) return;
    f32x4 acc[2][2][4][2];
#pragma unroll
    for (int a = 0; a < 2; ++a)
#pragma unroll
        for (int b = 0; b < 2; ++b)
#pragma unroll
            for (int m = 0; m < 4; ++m)
#pragma unroll
                for (int n = 0; n < 2; ++n) acc[a][b][m][n] = (f32x4){fz, fz, fz, fz};
    bf16x8 At[4][2], B0[2][2], B1[2][2];
    const char* cA = (const char*)g.A + (size_t)cur.pm * tstepA + (size_t)cur.koff * 2; const char* cB = (const char*)g.Bt + (size_t)cur.pn * tstepB + (size_t)cur.koff * 2;
    PG8_STAGE(PG8_SB(0, 0), cB, voffB); PG8_STAGE(PG8_SB(0, 1), cB + hstepB, voffB); PG8_STAGE(PG8_SA(0, 0), cA, voffA); PG8_STAGE(PG8_SA(0, 1), cA + hstepA, voffA);
    if (wr == 1) PG8_BAR;
    PG8_WAIT_V(2); PG8_BAR;
    PG8_STAGE(PG8_SB(1, 0), cB + kstep, voffB); PG8_STAGE(PG8_SA(1, 0), cA + kstep, voffA); PG8_STAGE(PG8_SB(1, 1), cB + hstepB + kstep, voffB);
    PG8_WAIT_V(6); PG8_BAR;
    for (;;) {
        const bool has_next = S.next(ui + 1, nxt);
        const char* nA = has_next ? (const char*)g.A + (size_t)nxt.pm * tstepA + (size_t)nxt.koff * 2 : cA; const char* nB = has_next ? (const char*)g.Bt + (size_t)nxt.pn * tstepB + (size_t)nxt.koff * 2 : cB;
        const int nt = cur.nt;
        for (int t = 0; t < nt; t += 2) {
            const bool last = (t == nt - 2);
            const char* a1 = cA + (size_t)(t + 1) * kstep;
            const char* a2 = last ? nA : cA + (size_t)(t + 2) * kstep; const char* b2 = last ? nB : cB + (size_t)(t + 2) * kstep;
            const char* a3 = a2 + kstep; const char* b3 = b2 + kstep;
            PG8_LDB(B0, 0, 0); PG8_LDB(B1, 0, 1); PG8_SCHED; PG8_LDA(At, 0, 0); PG8_STAGE(PG8_SA(1, 1), a1 + hstepA, voffA);
            PG8_WAIT_V(8); PG8_WAIT_L(0); PG8_BAR; PG8_MMA(0, 0, At, B0); PG8_MMA(0, 1, At, B1); PG8_BAR; PG8_SCHED;
            PG8_LDA(At, 0, 1); PG8_STAGE(PG8_SB(0, 0), b2, voffB); PG8_STAGE(PG8_SB(0, 1), b2 + hstepB, voffB); PG8_STAGE(PG8_SA(0, 0), a2, voffA);
            PG8_WAIT_V(8); PG8_WAIT_L(0); PG8_BAR; PG8_MMA(1, 0, At, B0); PG8_MMA(1, 1, At, B1); PG8_BAR; PG8_SCHED;
            PG8_LDB(B0, 1, 0); PG8_LDB(B1, 1, 1); PG8_SCHED; PG8_LDA(At, 1, 0); PG8_STAGE(PG8_SA(0, 1), a2 + hstepA, voffA);
            PG8_WAIT_V(8); PG8_WAIT_L(0); PG8_BAR; PG8_MMA(0, 0, At, B0); PG8_MMA(0, 1, At, B1); PG8_BAR; PG8_SCHED;
            PG8_LDA(At, 1, 1); PG8_STAGE(PG8_SB(1, 0), b3, voffB); PG8_STAGE(PG8_SB(1, 1), b3 + hstepB, voffB); PG8_STAGE(PG8_SA(1, 0), a3, voffA);
            PG8_WAIT_V(8); PG8_WAIT_L(0); PG8_BAR; PG8_MMA(1, 0, At, B0); PG8_MMA(1, 1, At, B1); PG8_BAR; PG8_SCHED;
        }
        if (wr == 0) PG8_BAR;
        const bool keep = E(acc, cur, wr, wc, fr, fq);
        if (!has_next) break;
        if (!keep) {
#pragma unroll
            for (int a = 0; a < 2; ++a)
#pragma unroll
                for (int b = 0; b < 2; ++b)
#pragma unroll
                    for (int m = 0; m < 4; ++m)
#pragma unroll
                        for (int n = 0; n < 2; ++n) acc[a][b][m][n] = (f32x4){fz, fz, fz, fz};
        }
        cur = nxt; cA = nA; cB = nB; ++ui;
        if (wr == 1) PG8_BAR;
    }
    PG8_WAIT_V(0);
    PG8_BAR;
#undef PG8_SA
#undef PG8_SB
#undef PG8_STAGE
#undef PG8_LDA
#undef PG8_LDB
#undef PG8_MMA
#undef PG8_WAIT_V
#undef PG8_WAIT_L
#undef PG8_BAR
#undef PG8_SCHED
}
}
using pg8::Unit;

struct EpiProj {
    static constexpr bool PERM = true;
    bf16_t* projc; float* logf; bf16_t* gates; const float* lb; int tok0; bf16_t* mixcat;
    DI bool operator()(f32x4 (&acc)[2][2][4][2], const Unit& u, int wr, int wc, int fr, int fq) const {
        const int row0 = u.pm * 256 + wr * 64 + fr;
        const int pn = u.pn;
        int kind;
        if (pn < 4) kind = 0; else if (pn < 10) kind = 1; else if (pn < 22) kind = 0; else if (pn < 26) kind = 2; else if (pn < 30) kind = 0;
        else if (pn < 38) kind = 3; else if (pn < 42) kind = 2; else kind = 4;
#pragma unroll
        for (int ai = 0; ai < 2; ++ai)
#pragma unroll
            for (int m = 0; m < 4; ++m) {
                const int row = row0 + ai * 128 + m * 16;
#pragma unroll
                for (int bj = 0; bj < 2; ++bj) {
                    const int col = pn * 256 + bj * 128 + wc * 32 + 8 * fq;
                    f32x4 v0 = acc[ai][bj][m][0], v1 = acc[ai][bj][m][1];
                    if (kind == 1) { v0 = v0 * 0.08838834764831845f; v1 = v1 * 0.08838834764831845f; }
                    else if (kind == 2) {
#pragma unroll
                        for (int e = 0; e < 4; ++e) { v0[e] = siluf_(v0[e]); v1[e] = siluf_(v1[e]); }
                    } else if (kind == 4) {
#pragma unroll
                        for (int e = 0; e < 4; ++e) { v0[e] = fmaxf(sigmoidf_(v0[e]), 1e-7f); v1[e] = fmaxf(sigmoidf_(v1[e]), 1e-7f); }
                    } else if (kind == 3) {
                        const int li = col - C_HFF;
                        const f32x4 l0 = *(const f32x4*)(lb + li), l1 = *(const f32x4*)(lb + li + 4);
                        f32x4 lf0, lf1;
#pragma unroll
                        for (int e = 0; e < 4; ++e) {
                            const float s0 = sigmoidf_(v0[e]), s1 = sigmoidf_(v1[e]);
                            lf0[e] = __logf(l0[e] + (1.f - l0[e]) * s0); lf1[e] = __logf(l1[e] + (1.f - l1[e]) * s1);
                            v0[e] = (1.f - l0[e]) * (1.f - s0); v1[e] = (1.f - l1[e]) * (1.f - s1);
                        }
                        float* lp = logf + (size_t)row * 2048 + li;
                        *(f32x4*)lp = lf0; *(f32x4*)(lp + 4) = lf1;
                    }
                    u32x4 w; w.x = cvt_pk_bf16(v0[0], v0[1]); w.y = cvt_pk_bf16(v0[2], v0[3]); w.z = cvt_pk_bf16(v1[0], v1[1]); w.w = cvt_pk_bf16(v1[2], v1[3]);
                    if (kind == 4) *(u32x4*)(gates + (size_t)(tok0 + row) * 3072 + (col - C_GATE)) = w;
                    else if (pn >= 38) *(u32x4*)(mixcat + (size_t)(tok0 + row) * MCW + 1536 + (col - C_HG)) = w;
                    else *(u32x4*)(projc + (size_t)row * PJW + col) = w;
                }
            }
        return false;
    }
};
struct EpiMerge {
    static constexpr bool PERM = true;
    const bf16_t* gates; bf16_t* merged;
    DI bool operator()(f32x4 (&acc)[2][2][4][2], const Unit& u, int wr, int wc, int fr, int fq) const {
        const int row0 = u.pm * 256 + wr * 64 + fr;
#pragma unroll
        for (int ai = 0; ai < 2; ++ai)
#pragma unroll
            for (int m = 0; m < 4; ++m) {
                const int row = row0 + ai * 128 + m * 16;
#pragma unroll
                for (int bj = 0; bj < 2; ++bj) {
                    const int col = u.pn * 256 + bj * 128 + wc * 32 + 8 * fq;
                    const bf16_t* gp = gates + (size_t)row * 3072 + col;
                    f32x4& v0 = acc[ai][bj][m][0]; f32x4& v1 = acc[ai][bj][m][1];
                    if (u.seg < 2) {
                        const u32x4 gn = *(const u32x4*)(gp + u.seg * 1024), gd = *(const u32x4*)(gp + (u.seg + 1) * 1024);
                        v0[0] *= bf_lo(gn.x) * __builtin_amdgcn_rcpf(bf_lo(gd.x)); v0[1] *= bf_hi(gn.x) * __builtin_amdgcn_rcpf(bf_hi(gd.x));
                        v0[2] *= bf_lo(gn.y) * __builtin_amdgcn_rcpf(bf_lo(gd.y)); v0[3] *= bf_hi(gn.y) * __builtin_amdgcn_rcpf(bf_hi(gd.y));
                        v1[0] *= bf_lo(gn.z) * __builtin_amdgcn_rcpf(bf_lo(gd.z)); v1[1] *= bf_hi(gn.z) * __builtin_amdgcn_rcpf(bf_hi(gd.z));
                        v1[2] *= bf_lo(gn.w) * __builtin_amdgcn_rcpf(bf_lo(gd.w)); v1[3] *= bf_hi(gn.w) * __builtin_amdgcn_rcpf(bf_hi(gd.w));
                    } else {
                        const u32x4 gn = *(const u32x4*)(gp + 2048);
                        u32x4 w; w.x = cvt_pk_bf16(v0[0] * bf_lo(gn.x), v0[1] * bf_hi(gn.x)); w.y = cvt_pk_bf16(v0[2] * bf_lo(gn.y), v0[3] * bf_hi(gn.y));
                        w.z = cvt_pk_bf16(v1[0] * bf_lo(gn.z), v1[1] * bf_hi(gn.z)); w.w = cvt_pk_bf16(v1[2] * bf_lo(gn.w), v1[3] * bf_hi(gn.w));
                        *(u32x4*)(merged + (size_t)row * DM + col) = w;
                    }
                }
            }
        return u.seg < 2;
    }
};
struct EpiOut {
    static constexpr bool PERM = false;
    const float* xres; float* X;
    DI bool operator()(f32x4 (&acc)[2][2][4][2], const Unit& u, int wr, int wc, int fr, int fq) const {
        const int row0 = u.pm * 256 + wr * 64 + fr;
#pragma unroll
        for (int ai = 0; ai < 2; ++ai)
#pragma unroll
            for (int m = 0; m < 4; ++m) {
                const size_t rb = (size_t)(row0 + ai * 128 + m * 16) * DM;
#pragma unroll
                for (int bj = 0; bj < 2; ++bj)
#pragma unroll
                    for (int n = 0; n < 2; ++n) {
                        const int col = u.pn * 256 + bj * 128 + wc * 32 + 16 * n + 4 * fq;
                        const f32x4 r = *(const f32x4*)(xres + rb + col);
                        *(f32x4*)(X + rb + col) = r * ALPHA + acc[ai][bj][m][n];
                    }
            }
        return false;
    }
};
struct EpiFfn {
    static constexpr bool PERM = true;
    bf16_t* hidden; bf16_t* pg;
    DI bool operator()(f32x4 (&acc)[2][2][4][2], const Unit& u, int wr, int wc, int fr, int fq) const {
        const int row0 = u.pm * 256 + wr * 64 + fr;
#pragma unroll
        for (int ai = 0; ai < 2; ++ai)
#pragma unroll
            for (int m = 0; m < 4; ++m) {
                const int row = row0 + ai * 128 + m * 16;
                if (u.pn < 22) {
                    const f32x4 g0 = acc[ai][0][m][0], g1 = acc[ai][0][m][1], u0 = acc[ai][1][m][0], u1 = acc[ai][1][m][1];
                    u32x4 w; w.x = cvt_pk_bf16(siluf_(g0[0]) * u0[0], siluf_(g0[1]) * u0[1]); w.y = cvt_pk_bf16(siluf_(g0[2]) * u0[2], siluf_(g0[3]) * u0[3]);
                    w.z = cvt_pk_bf16(siluf_(g1[0]) * u1[0], siluf_(g1[1]) * u1[1]); w.w = cvt_pk_bf16(siluf_(g1[2]) * u1[2], siluf_(g1[3]) * u1[3]);
                    *(u32x4*)(hidden + (size_t)row * HDW + u.pn * 128 + wc * 32 + 8 * fq) = w;
                } else {
#pragma unroll
                    for (int bj = 0; bj < 2; ++bj) {
                        const f32x4 v0 = acc[ai][bj][m][0], v1 = acc[ai][bj][m][1];
                        u32x4 w; w.x = cvt_pk_bf16(sigmoidf_(v0[0]), sigmoidf_(v0[1])); w.y = cvt_pk_bf16(sigmoidf_(v0[2]), sigmoidf_(v0[3]));
                        w.z = cvt_pk_bf16(sigmoidf_(v1[0]), sigmoidf_(v1[1])); w.w = cvt_pk_bf16(sigmoidf_(v1[2]), sigmoidf_(v1[3]));
                        *(u32x4*)(pg + (size_t)row * DM + (u.pn - 22) * 256 + bj * 128 + wc * 32 + 8 * fq) = w;
                    }
                }
            }
        return false;
    }
};
struct EpiDown {
    static constexpr bool PERM = false;
    const bf16_t* pg; float* X;
    DI bool operator()(f32x4 (&acc)[2][2][4][2], const Unit& u, int wr, int wc, int fr, int fq) const {
        const int row0 = u.pm * 256 + wr * 64 + fr;
#pragma unroll
        for (int ai = 0; ai < 2; ++ai)
#pragma unroll
            for (int m = 0; m < 4; ++m) {
                const size_t rb = (size_t)(row0 + ai * 128 + m * 16) * DM;
#pragma unroll
                for (int bj = 0; bj < 2; ++bj)
#pragma unroll
                    for (int n = 0; n < 2; ++n) {
                        const int col = u.pn * 256 + bj * 128 + wc * 32 + 16 * n + 4 * fq;
                        if (u.seg == 0) {
                            const u32x2 gq = *(const u32x2*)(pg + rb + col);
                            f32x4& v = acc[ai][bj][m][n];
                            v[0] *= bf_lo(gq.x); v[1] *= bf_hi(gq.x); v[2] *= bf_lo(gq.y); v[3] *= bf_hi(gq.y);
                        } else {
                            const f32x4 r = *(const f32x4*)(X + rb + col);
                            *(f32x4*)(X + rb + col) = r * ALPHA + acc[ai][bj][m][n];
                        }
                    }
            }
        return u.seg == 0;
    }
};

struct Args { const float* in[20]; float* out; unsigned char* ws; int ph_lo, ph_hi; };
enum { I_X = 0, I_P, I_WIN, I_POOLW, I_POOLS, I_WBA, I_WBB, I_WBC, I_LBL, I_HNW, I_WOUT, I_LN1G, I_LN1B, I_WFG, I_WFU, I_WFD, I_WPP, I_WPG, I_LN2G, I_LN2B };

struct Ctx {
    LAS unsigned char* lds; int tid, lane, wave, G, gw, NGW;
};

DI void tr_item(const float* W, int ld_src, int k0, int n0, bf16_t* dst, int ld_dst, int drow0, int dcol0, LAS float* scr, int lane) {
    float tv[32];
#pragma unroll
    for (int i = 0; i < 32; ++i) { const int kk = 2 * i + (lane >> 5); tv[i] = W[(size_t)(k0 + kk) * ld_src + n0 + (lane & 31)]; }
#pragma unroll
    for (int i = 0; i < 32; ++i) { const int kk = 2 * i + (lane >> 5); scr[kk * 33 + (lane & 31)] = tv[i]; }
    asm volatile("s_waitcnt lgkmcnt(0)" ::: "memory");
    const int c = lane & 7;
#pragma unroll
    for (int j = 0; j < 4; ++j) { const int n = (lane >> 3) + 8 * j; const LAS float* s = scr + (8 * c) * 33 + n;
        u32x4 o; o.x = cvt_pk_bf16(s[0 * 33], s[1 * 33]); o.y = cvt_pk_bf16(s[2 * 33], s[3 * 33]); o.z = cvt_pk_bf16(s[4 * 33], s[5 * 33]); o.w = cvt_pk_bf16(s[6 * 33], s[7 * 33]);
        *(u32x4*)(dst + (size_t)(drow0 + n) * ld_dst + dcol0 + 8 * c) = o; }
    asm volatile("s_waitcnt lgkmcnt(0)" ::: "memory");
}

DI void conv_weights(const Ctx& C, const Args& a, int z, int layer) {
    unsigned char* ws = a.ws + (size_t)z;
    LAS float* scr = (LAS float*)(C.lds + C.wave * 16384);
    bf16_t* WinT = (bf16_t*)(ws + WS_WIN); bf16_t* WcatT = (bf16_t*)(ws + WS_WCAT); bf16_t* WoutT = (bf16_t*)(ws + WS_WOUT); bf16_t* WguT = (bf16_t*)(ws + WS_WGU); bf16_t* WdpT = (bf16_t*)(ws + WS_WDP);
    const float* w_in = a.in[I_WIN + z] + (size_t)layer * DM * INW;
    const float* wbb = a.in[I_WBB + z] + (size_t)layer * 512 * DM; const float* wbc = a.in[I_WBC + z] + (size_t)layer * DM * DM; const float* wba = a.in[I_WBA + z] + (size_t)layer * DM * DM;
    const float* wout = a.in[I_WOUT + z] + (size_t)layer * DM * DM;
    const float* wfg = a.in[I_WFG + z] + (size_t)layer * DM * FFH; const float* wfu = a.in[I_WFU + z] + (size_t)layer * DM * FFH; const float* wfd = a.in[I_WFD + z] + (size_t)layer * FFH * DM;
    const float* wpp = a.in[I_WPP + z] + (size_t)layer * PLE * DM; const float* wpg = a.in[I_WPG + z] + (size_t)layer * DM * DM;
    const float* poolw = a.in[I_POOLW + z] + (size_t)layer * 4 * 256 * 256; const float* pools = a.in[I_POOLS + z] + (size_t)layer * DM;
    constexpr int N_IN = 16 * 432, N_BB = 8 * 32, N_BC = 16 * 32, N_OUT = 16 * 32, N_FG = 16 * 88, N_FU = 16 * 88, N_PG = 16 * 32, N_FD = 44 * 32, N_PP = 4 * 32, N_PA = 128 * 16;
    constexpr int NTOT = N_IN + N_BB + N_BC + N_OUT + N_FG + N_FU + N_PG + N_FD + N_PP + N_PA;
    for (int it = C.gw; it < NTOT; it += C.NGW) {
        int r = it;
        if (r < N_IN) { const int kb = r / 432, nb = r % 432; tr_item(w_in, INW, 64 * kb, 32 * nb, WinT, DM, 32 * nb, 64 * kb, scr, C.lane); continue; } r -= N_IN;
        if (r < N_BB) { const int kb = r / 32, nb = r % 32; tr_item(wbb, DM, 64 * kb, 32 * nb, WcatT, MCW, 32 * nb, 1024 + 64 * kb, scr, C.lane); continue; } r -= N_BB;
        if (r < N_BC) { const int kb = r / 32, nb = r % 32; tr_item(wbc, DM, 64 * kb, 32 * nb, WcatT, MCW, 32 * nb, 1536 + 64 * kb, scr, C.lane); continue; } r -= N_BC;
        if (r < N_OUT) { const int kb = r / 32, nb = r % 32; tr_item(wout, DM, 64 * kb, 32 * nb, WoutT, DM, 32 * nb, 64 * kb, scr, C.lane); continue; } r -= N_OUT;
        if (r < N_FG) { const int kb = r / 88, nb = r % 88, n0 = 32 * nb; tr_item(wfg, FFH, 64 * kb, n0, WguT, DM, 256 * (n0 >> 7) + (n0 & 127), 64 * kb, scr, C.lane); continue; } r -= N_FG;
        if (r < N_FU) { const int kb = r / 88, nb = r % 88, n0 = 32 * nb; tr_item(wfu, FFH, 64 * kb, n0, WguT, DM, 256 * (n0 >> 7) + 128 + (n0 & 127), 64 * kb, scr, C.lane); continue; } r -= N_FU;
        if (r < N_PG) { const int kb = r / 32, nb = r % 32; tr_item(wpg, DM, 64 * kb, 32 * nb, WguT, DM, 5632 + 32 * nb, 64 * kb, scr, C.lane); continue; } r -= N_PG;
        if (r < N_FD) { const int kb = r / 32, nb = r % 32; tr_item(wfd, DM, 64 * kb, 32 * nb, WdpT, HDW, 32 * nb, 64 * kb, scr, C.lane); continue; } r -= N_FD;
        if (r < N_PP) { const int kb = r / 32, nb = r % 32; tr_item(wpp, DM, 64 * kb, 32 * nb, WdpT, HDW, 32 * nb, FFH + 64 * kb, scr, C.lane); continue; } r -= N_PP;
        {
            const int ko = r >> 4, nb = r & 15, k0 = ko * 8, g = k0 >> 8, n = nb * 64 + C.lane;
            float acc8[8];
#pragma unroll
            for (int j = 0; j < 8; ++j) acc8[j] = 0.f;
            const float* pw = poolw + (size_t)g * 65536 + (size_t)(k0 & 255) * 256;
            {
                const int j = C.lane >> 3, cb = (C.lane & 7) * 32;
#pragma unroll
                for (int q = 0; q < 8; ++q) { const f32x4 pv = *(const f32x4*)(pw + j * 256 + cb + 4 * q), sv = *(const f32x4*)(pools + g * 256 + cb + 4 * q);
                    *(LAS f32x4*)(scr + j * 256 + cb + 4 * q) = pv * sv; }
                asm volatile("s_waitcnt lgkmcnt(0)" ::: "memory");
            }
#pragma unroll 1
            for (int c0 = 0; c0 < 256; c0 += 16) {
                float wa[16];
#pragma unroll
                for (int u = 0; u < 16; ++u) wa[u] = wba[(size_t)(g * 256 + c0 + u) * DM + n];
#pragma unroll
                for (int u4 = 0; u4 < 4; ++u4)
#pragma unroll
                    for (int j = 0; j < 8; ++j) { const f32x4 p4 = *(const LAS f32x4*)(scr + j * 256 + c0 + 4 * u4);
                        acc8[j] += p4[0] * wa[4 * u4] + p4[1] * wa[4 * u4 + 1] + p4[2] * wa[4 * u4 + 2] + p4[3] * wa[4 * u4 + 3]; }
            }
            asm volatile("s_waitcnt lgkmcnt(0)" ::: "memory");
            u32x4 o; o.x = cvt_pk_bf16(acc8[0], acc8[1]); o.y = cvt_pk_bf16(acc8[2], acc8[3]); o.z = cvt_pk_bf16(acc8[4], acc8[5]); o.w = cvt_pk_bf16(acc8[6], acc8[7]);
            *(u32x4*)(WcatT + (size_t)n * MCW + k0) = o;
        }
    }
}

template <int NR>
DI void ln_rows(float* xrow, bf16_t* orow, const float* g, const float* b, int lane) {
    f32x4 v[NR][4]; float s[NR];
#pragma unroll
    for (int r = 0; r < NR; ++r)
#pragma unroll
        for (int j = 0; j < 4; ++j) v[r][j] = *((const f32x4*)(xrow + (size_t)r * DM) + lane + 64 * j);
#pragma unroll
    for (int r = 0; r < NR; ++r) { s[r] = 0.f;
#pragma unroll
        for (int j = 0; j < 4; ++j) s[r] += (v[r][j].x + v[r][j].y) + (v[r][j].z + v[r][j].w); }
#pragma unroll
    for (int r = 0; r < NR; ++r) s[r] = wave_sum(s[r], lane) * (1.f / DM);
    float s2[NR];
#pragma unroll
    for (int r = 0; r < NR; ++r) { s2[r] = 0.f;
#pragma unroll
        for (int j = 0; j < 4; ++j) { v[r][j] = v[r][j] - s[r]; s2[r] += (v[r][j].x * v[r][j].x + v[r][j].y * v[r][j].y) + (v[r][j].z * v[r][j].z + v[r][j].w * v[r][j].w); } }
#pragma unroll
    for (int r = 0; r < NR; ++r) s2[r] = 1.f / sqrtf(wave_sum(s2[r], lane) * (1.f / DM) + LN_EPS);
#pragma unroll
    for (int j = 0; j < 4; ++j) {
        const f32x4 gg = *((const f32x4*)g + lane + 64 * j), bb = *((const f32x4*)b + lane + 64 * j);
#pragma unroll
        for (int r = 0; r < NR; ++r) {
            const f32x4 y = v[r][j] * s2[r] * gg + bb;
            *((f32x4*)(xrow + (size_t)r * DM) + lane + 64 * j) = y;
            u32x2 w; w.x = cvt_pk_bf16(y.x, y.y); w.y = cvt_pk_bf16(y.z, y.w); *((u32x2*)(orow + (size_t)r * DM) + lane + 64 * j) = w;
        }
    }
}

DI void pool_task(const Ctx& C, int wt, const bf16_t* projc, bf16_t* mixcat, int tok0) {
    const int tl = wt >> 1, c0 = (wt & 1) * 512 + C.lane * 8, g = c0 >> 8, half = 1 << g;
    const int t = tl % SEQ, base = tl - t;
    const int lo = (t - half) < 0 ? 0 : (t - half), hi = (t + half) > SEQ ? SEQ : (t + half);
    float s[8];
#pragma unroll
    for (int j = 0; j < 8; ++j) s[j] = 0.f;
    u32x4 pv[16];
#pragma unroll
    for (int q = 0; q < 16; ++q) { const int row = t - half + q; const bool ok = (q < 2 * half) && (row >= 0) && (row < SEQ);
        pv[q] = ok ? *(const u32x4*)(projc + (size_t)(base + row) * PJW + C_POOL + c0) : (u32x4){0u, 0u, 0u, 0u}; }
#pragma unroll
    for (int q = 0; q < 16; ++q) { const u32x4 v = pv[q];
        s[0] += bf_lo(v.x); s[1] += bf_hi(v.x); s[2] += bf_lo(v.y); s[3] += bf_hi(v.y); s[4] += bf_lo(v.z); s[5] += bf_hi(v.z); s[6] += bf_lo(v.w); s[7] += bf_hi(v.w); }
    const float inv = 1.f / (float)(hi - lo);
    const u32x4 v = *(const u32x4*)(projc + (size_t)tl * PJW + C_POOL + c0);
    u32x4 o; o.x = cvt_pk_bf16(s[0] * inv - bf_lo(v.x), s[1] * inv - bf_hi(v.x)); o.y = cvt_pk_bf16(s[2] * inv - bf_lo(v.y), s[3] * inv - bf_hi(v.y));
    o.z = cvt_pk_bf16(s[4] * inv - bf_lo(v.z), s[5] * inv - bf_hi(v.z)); o.w = cvt_pk_bf16(s[6] * inv - bf_lo(v.w), s[7] * inv - bf_hi(v.w));
    *(u32x4*)(mixcat + (size_t)(tok0 + tl) * MCW + c0) = o;
}

typedef float f32x16 __attribute__((ext_vector_type(16)));
#define MFMA32(a, b, c) __builtin_amdgcn_mfma_f32_32x32x16_bf16((a), (b), (c), 0, 0, 0)
constexpr int HG_QS = 272, HG_KTS = 80, HG_E1S = 528;
constexpr int HG_QE = 0, HG_KE = 8704, HG_KDT = 17408, HG_VV = 27648, HG_DEC = 29696, HG_E1 = 30208, HG_LDS = 47104;
DI bf16x8 pack8(const f32x16& x, int s) {
    u32x4 p; p.x = cvt_pk_bf16(x[8 * s], x[8 * s + 1]); p.y = cvt_pk_bf16(x[8 * s + 2], x[8 * s + 3]); p.z = cvt_pk_bf16(x[8 * s + 4], x[8 * s + 5]); p.w = cvt_pk_bf16(x[8 * s + 6], x[8 * s + 7]);
    return __builtin_bit_cast(bf16x8, p);
}
constexpr int HP_QE = 0, HP_KE = 8704, HP_KDT = 17408, HP_VV = 27648, HP_VS = 272, HP_LDS = 36352;
DI void hgrn_prep_task(const Ctx& C, int task, const bf16_t* projc, const float* logf, float* ohg, u32x4* QF, u32x4* KF, u32x4* VF, float* DCb, LAS unsigned char* L) {
    const int n = task & 127, h = (task >> 7) & 7, bl = task >> 10;
    const int lane = C.lane, r32 = lane & 31, hi = lane >> 5;
    const size_t rowb = (size_t)bl * SEQ + (size_t)n * 32;
    bf16x8 PA0, PA1, PB0, PB1;
    {
        const int s = lane >> 1, vh = (lane & 1) * 64; const bf16_t* src = projc + (rowb + s) * PJW + C_HI + h * 128 + vh;
#pragma unroll
        for (int hf = 0; hf < 2; ++hf) { u32x4 t[4];
#pragma unroll
            for (int i = 0; i < 4; ++i) t[i] = *(const u32x4*)(src + 8 * (4 * hf + i));
#pragma unroll
            for (int i = 0; i < 4; ++i) *(LAS u32x4*)(L + HP_VV + s * HP_VS + vh * 2 + (4 * hf + i) * 16) = t[i]; }
    }
#pragma unroll 1
    for (int dir = 0; dir < 2; ++dir) {
        const int item = (bl * 8 + h) * 2 + dir;
        const int cq = C_HQ + h * 128, ck = C_HFF + dir * 1024 + h * 128, cf = dir * 1024 + h * 128;
        {
            const int ep = 2 * lane;
            f32x2 bb[32]; unsigned kk[32];
#pragma unroll
            for (int s = 0; s < 32; ++s) { bb[s] = *(const f32x2*)(logf + (rowb + s) * 2048 + cf + ep); kk[s] = *(const unsigned*)(projc + (rowb + s) * PJW + ck + ep); }
            f32x2 be;
            if (dir == 0) {
#pragma unroll
                for (int s = 1; s < 32; ++s) bb[s] = bb[s] + bb[s - 1];
                be = bb[31];
            } else {
#pragma unroll
                for (int s = 30; s >= 0; --s) bb[s] = bb[s] + bb[s + 1];
                be = bb[0];
            }
#pragma unroll
            for (int s = 0; s < 32; ++s) *(LAS f32x2*)(L + s * HG_E1S + ep * 4) = bb[s];
            *(f32x2*)(DCb + ((size_t)item * 128 + n) * 256 + ep) = (f32x2){__expf(be.x), __expf(be.y)};
#pragma unroll
            for (int i = 0; i < 4; ++i) {
                u32x4 w0, w1;
#pragma unroll
                for (int j = 0; j < 4; ++j) { const int s0 = 8 * i + 2 * j;
                    w0[j] = cvt_pk_bf16(bf_lo(kk[s0]) * __expf(be.x - bb[s0].x), bf_lo(kk[s0 + 1]) * __expf(be.x - bb[s0 + 1].x));
                    w1[j] = cvt_pk_bf16(bf_hi(kk[s0]) * __expf(be.y - bb[s0].y), bf_hi(kk[s0 + 1]) * __expf(be.y - bb[s0 + 1].y)); }
                *(LAS u32x4*)(L + HP_KDT + ep * HG_KTS + i * 16) = w0; *(LAS u32x4*)(L + HP_KDT + (ep + 1) * HG_KTS + i * 16) = w1;
            }
        }
        asm volatile("s_waitcnt lgkmcnt(0)" ::: "memory");
        {
            const int s = lane >> 1, eh = (lane & 1) * 64;
            u32x4 qrow[8], krow_[8];
            { const bf16_t* qp = projc + (rowb + s) * PJW + cq + eh; const bf16_t* kp = projc + (rowb + s) * PJW + ck + eh;
#pragma unroll
              for (int i = 0; i < 8; ++i) { qrow[i] = *(const u32x4*)(qp + 8 * i); krow_[i] = *(const u32x4*)(kp + 8 * i); } }
            f32x4 bv[16];
#pragma unroll
            for (int i = 0; i < 16; ++i) bv[i] = *(const LAS f32x4*)(L + s * HG_E1S + (eh + 4 * i) * 4);
            asm volatile("s_waitcnt lgkmcnt(0)" ::: "memory");
#pragma unroll
            for (int i = 0; i < 8; ++i) {
                const u32x4 qv = qrow[i], kv = krow_[i];
                float e[8], ie[8];
#pragma unroll
                for (int j = 0; j < 4; ++j) { e[j] = __expf(fmaxf(bv[2 * i][j], -80.f)); e[4 + j] = __expf(fmaxf(bv[2 * i + 1][j], -80.f)); }
#pragma unroll
                for (int j = 0; j < 8; ++j) ie[j] = __builtin_amdgcn_rcpf(e[j]);
                u32x4 qo, ko;
                qo.x = cvt_pk_bf16(bf_lo(qv.x) * e[0], bf_hi(qv.x) * e[1]); qo.y = cvt_pk_bf16(bf_lo(qv.y) * e[2], bf_hi(qv.y) * e[3]);
                qo.z = cvt_pk_bf16(bf_lo(qv.z) * e[4], bf_hi(qv.z) * e[5]); qo.w = cvt_pk_bf16(bf_lo(qv.w) * e[6], bf_hi(qv.w) * e[7]);
                ko.x = cvt_pk_bf16(bf_lo(kv.x) * ie[0], bf_hi(kv.x) * ie[1]); ko.y = cvt_pk_bf16(bf_lo(kv.y) * ie[2], bf_hi(kv.y) * ie[3]);
                ko.z = cvt_pk_bf16(bf_lo(kv.z) * ie[4], bf_hi(kv.z) * ie[5]); ko.w = cvt_pk_bf16(bf_lo(kv.w) * ie[6], bf_hi(kv.w) * ie[7]);
                *(LAS u32x4*)(L + HP_QE + s * HG_QS + (eh + 8 * i) * 2) = qo; *(LAS u32x4*)(L + HP_KE + s * HG_QS + (eh + 8 * i) * 2) = ko;
            }
        }
        asm volatile("s_waitcnt lgkmcnt(0)" ::: "memory");
        {
            f32x16 at;
#pragma unroll
            for (int r = 0; r < 16; ++r) at[r] = 0.f;
            bf16x8 fa[8], fb[8];
#pragma unroll
            for (int ks = 0; ks < 8; ++ks) { fa[ks] = *(const LAS bf16x8*)(L + HP_KE + r32 * HG_QS + (ks * 16 + 8 * hi) * 2); fb[ks] = *(const LAS bf16x8*)(L + HP_QE + r32 * HG_QS + (ks * 16 + 8 * hi) * 2); }
            __builtin_amdgcn_sched_barrier(0);
            asm volatile("s_waitcnt lgkmcnt(0)" ::: "memory");
            __builtin_amdgcn_sched_barrier(0);
#pragma unroll
            for (int ks = 0; ks < 8; ++ks) at = MFMA32(fa[ks], fb[ks], at);
#pragma unroll
            for (int r = 0; r < 16; ++r) { const int srow = (r & 3) + 8 * (r >> 2) + 4 * hi; const bool keep = dir ? (srow >= r32) : (srow <= r32); at[r] = keep ? at[r] : 0.f; }
            if (dir == 0) { PA0 = pack8(at, 0); PA1 = pack8(at, 1); } else { PB0 = pack8(at, 0); PB1 = pack8(at, 1); }
        }
        {
            u32x4* qfp = QF + (((size_t)item * 128 + n) * 8) * 64 + lane; u32x4* kfp = KF + (((size_t)item * 128 + n) * 8) * 64 + lane;
            u32x2 qa[8][2], ka[8][2];
#pragma unroll
            for (int b = 0; b < 4; ++b)
#pragma unroll
                for (int sp = 0; sp < 2; ++sp) {
                    qa[b * 2 + sp][0] = *(const LAS u32x2*)(L + HP_QE + r32 * HG_QS + (b * 32 + 16 * sp + 4 * hi) * 2); qa[b * 2 + sp][1] = *(const LAS u32x2*)(L + HP_QE + r32 * HG_QS + (b * 32 + 16 * sp + 8 + 4 * hi) * 2);
                    ka[b * 2 + sp][0] = *(const LAS u32x2*)(L + HP_KDT + (b * 32 + r32) * HG_KTS + (16 * sp + 4 * hi) * 2); ka[b * 2 + sp][1] = *(const LAS u32x2*)(L + HP_KDT + (b * 32 + r32) * HG_KTS + (16 * sp + 8 + 4 * hi) * 2);
                }
            __builtin_amdgcn_sched_barrier(0);
            asm volatile("s_waitcnt lgkmcnt(0)" ::: "memory");
            __builtin_amdgcn_sched_barrier(0);
#pragma unroll
            for (int f = 0; f < 8; ++f) { qfp[f * 64] = (u32x4){qa[f][0].x, qa[f][0].y, qa[f][1].x, qa[f][1].y}; kfp[f * 64] = (u32x4){ka[f][0].x, ka[f][0].y, ka[f][1].x, ka[f][1].y}; }
        }
        asm volatile("s_waitcnt lgkmcnt(0)" ::: "memory");
    }
#pragma unroll
    for (int vs = 0; vs < 4; ++vs) {
        bf16x8 v0, v1;
#pragma unroll
        for (int j = 0; j < 8; ++j) { v0[j] = (short)*(const LAS bf16_t*)(L + HP_VV + (8 * (j >> 2) + 4 * hi + (j & 3)) * HP_VS + (vs * 32 + r32) * 2);
                                      v1[j] = (short)*(const LAS bf16_t*)(L + HP_VV + (16 + 8 * (j >> 2) + 4 * hi + (j & 3)) * HP_VS + (vs * 32 + r32) * 2); }
        f32x16 o;
#pragma unroll
        for (int r = 0; r < 16; ++r) o[r] = 0.f;
        o = MFMA32(PA0, v0, o); o = MFMA32(PA1, v1, o); o = MFMA32(PB0, v0, o); o = MFMA32(PB1, v1, o);
        u32x4* vfp = VF + ((((size_t)(bl * 8 + h) * 128 + n) * 4 + vs) * 2) * 64 + lane; vfp[0] = __builtin_bit_cast(u32x4, v0); vfp[64] = __builtin_bit_cast(u32x4, v1);
#pragma unroll
        for (int r = 0; r < 16; ++r) { const int t = (r & 3) + 8 * (r >> 2) + 4 * hi; ohg[(rowb + t) * DM + h * 128 + vs * 32 + r32] = o[r]; }
    }
    asm volatile("s_waitcnt lgkmcnt(0)" ::: "memory");
}

constexpr int HS_SLOT = 19456, HS_NSLOT = 4, HS_ORING = HS_NSLOT * HS_SLOT, HS_DSR = HS_ORING + 2 * 4096, HS_CTL = HS_DSR + 2 * 16384, HS_END = HS_CTL + 512;
DI unsigned lds_poll(LAS unsigned char* p) { return *(volatile LAS unsigned*)p; }
DI void hgrn_scan_role(const Ctx& C, int role, int ht, const u32x4* QF, const u32x4* KF, const u32x4* VF, const float* DCb, float* ohg, float* OIF0, float* OIF1, LAS unsigned char* L) {
    const int vs = ht & 3, dir = (ht >> 2) & 1, h = (ht >> 3) & 7, bl = ht >> 6;
    const int lane = C.lane, r32 = lane & 31, hi = lane >> 5;
    const int item = (bl * 8 + h) * 2 + dir, bh = bl * 8 + h;
    LAS unsigned char* w_ready = L + HS_CTL; LAS unsigned char* w_cons = L + HS_CTL + 64; LAS unsigned char* w_oready = L + HS_CTL + 128; LAS unsigned char* w_ofree = L + HS_CTL + 192;
    LAS unsigned char* w_dsready = L + HS_CTL + 256; LAS unsigned char* w_dsfree = L + HS_CTL + 320; LAS unsigned char* w_cons2 = L + HS_CTL + 384;
    if (role == 1) {
        int seen = 0;
        for (int j = 0; j < 128; ++j) {
            if (seen + HS_NSLOT <= j) { for (;;) { const int c0 = (int)lds_poll(w_cons), c1 = (int)lds_poll(w_cons2); seen = c0 < c1 ? c0 : c1; if (seen + HS_NSLOT > j) break; __builtin_amdgcn_s_sleep(1); } }
            const int n_ = dir ? 127 - j : j; const int slot_ = (j & (HS_NSLOT - 1)) * HS_SLOT;
            const u32x4* q_ = QF + (((size_t)item * 128 + n_) * 8) * 64 + lane; const u32x4* k_ = KF + (((size_t)item * 128 + n_) * 8) * 64 + lane;
            const u32x4* v_ = VF + ((((size_t)bh * 128 + n_) * 4 + vs) * 2) * 64 + lane; const u32x4* d_ = (const u32x4*)(DCb + ((size_t)item * 128 + n_) * 256) + lane;
#pragma unroll
            for (int f = 0; f < 8; ++f) __builtin_amdgcn_global_load_lds((const unsigned*)(q_ + f * 64), (LAS unsigned*)(L + slot_ + f * 1024), 16, 0, 0);
#pragma unroll
            for (int f = 0; f < 8; ++f) __builtin_amdgcn_global_load_lds((const unsigned*)(k_ + f * 64), (LAS unsigned*)(L + slot_ + 8192 + f * 1024), 16, 0, 0);
#pragma unroll
            for (int f = 0; f < 2; ++f) __builtin_amdgcn_global_load_lds((const unsigned*)(v_ + f * 64), (LAS unsigned*)(L + slot_ + 16384 + f * 1024), 16, 0, 0);
            __builtin_amdgcn_global_load_lds((const unsigned*)d_, (LAS unsigned*)(L + slot_ + 18432), 16, 0, 0);
            if (j >= 2) { asm volatile("s_waitcnt vmcnt(38)" ::: "memory"); *(volatile LAS unsigned*)w_ready = (unsigned)(j - 1); }
        }
        asm volatile("s_waitcnt vmcnt(19)" ::: "memory"); *(volatile LAS unsigned*)w_ready = 127u;
        asm volatile("s_waitcnt vmcnt(0)" ::: "memory"); *(volatile LAS unsigned*)w_ready = 128u;
        asm volatile("s_waitcnt lgkmcnt(0)" ::: "memory");
    } else if (role == 3) {
        int seen_ready = 0, seen_free = 0;
        for (int j = 0; j < 128; ++j) {
            const int slot = (j & (HS_NSLOT - 1)) * HS_SLOT;
            if (seen_ready <= j) { while ((seen_ready = (int)lds_poll(w_ready)) <= j) __builtin_amdgcn_s_sleep(1); }
            const bf16x8 vf0 = *(const LAS bf16x8*)(L + slot + 16384 + lane * 16), vf1 = *(const LAS bf16x8*)(L + slot + 17408 + lane * 16);
            bf16x8 kfr[8];
#pragma unroll
            for (int f = 0; f < 8; ++f) kfr[f] = *(const LAS bf16x8*)(L + slot + 8192 + f * 1024 + lane * 16);
            __builtin_amdgcn_sched_barrier(0);
            asm volatile("s_waitcnt lgkmcnt(0)" ::: "memory");
            __builtin_amdgcn_sched_barrier(0);
            f32x16 d4[4];
#pragma unroll
            for (int b = 0; b < 4; ++b)
#pragma unroll
                for (int r = 0; r < 16; ++r) d4[b][r] = 0.f;
#pragma unroll
            for (int b = 0; b < 4; ++b) d4[b] = MFMA32(kfr[b * 2], vf0, d4[b]);
#pragma unroll
            for (int b = 0; b < 4; ++b) d4[b] = MFMA32(kfr[b * 2 + 1], vf1, d4[b]);
            *(volatile LAS unsigned*)w_cons2 = (unsigned)(j + 1);
            if (seen_free + 2 <= j) { while ((seen_free = (int)lds_poll(w_dsfree)) + 2 <= j) __builtin_amdgcn_s_sleep(1); }
            LAS f32x4* dd = (LAS f32x4*)(L + HS_DSR + (j & 1) * 16384) + lane;
#pragma unroll
            for (int b = 0; b < 4; ++b)
#pragma unroll
                for (int g4 = 0; g4 < 4; ++g4) dd[(b * 4 + g4) * 64] = (f32x4){d4[b][4 * g4], d4[b][4 * g4 + 1], d4[b][4 * g4 + 2], d4[b][4 * g4 + 3]};
            asm volatile("s_waitcnt lgkmcnt(0)" ::: "memory");
            *(volatile LAS unsigned*)w_dsready = (unsigned)(j + 1);
        }
        asm volatile("s_waitcnt lgkmcnt(0)" ::: "memory");
    } else if (role == 0) {
        f32x16 S[4];
#pragma unroll
        for (int b = 0; b < 4; ++b)
#pragma unroll
            for (int r = 0; r < 16; ++r) S[b][r] = 0.f;
        int seen_ready = 0, seen_ds = 0, seen_ofree = 0;
        for (int i = 0; i < 128; ++i) {
            const int slot = (i & (HS_NSLOT - 1)) * HS_SLOT;
            if (seen_ready <= i) { while ((seen_ready = (int)lds_poll(w_ready)) <= i) __builtin_amdgcn_s_sleep(1); }
            bf16x8 qf[8];
#pragma unroll
            for (int f = 0; f < 8; ++f) qf[f] = *(const LAS bf16x8*)(L + slot + f * 1024 + lane * 16);
            __builtin_amdgcn_sched_barrier(0);
            asm volatile("s_waitcnt lgkmcnt(0)" ::: "memory");
            __builtin_amdgcn_sched_barrier(0);
            f32x16 o, o2;
#pragma unroll
            for (int r = 0; r < 16; ++r) { o[r] = 0.f; o2[r] = 0.f; }
#pragma unroll
            for (int b = 0; b < 4; ++b) {
                o = MFMA32(qf[b * 2], pack8(S[b], 0), o);
                o2 = MFMA32(qf[b * 2 + 1], pack8(S[b], 1), o2);
            }
            if (seen_ds <= i) { while ((seen_ds = (int)lds_poll(w_dsready)) <= i) __builtin_amdgcn_s_sleep(1); }
            const LAS f32x4* dd = (const LAS f32x4*)(L + HS_DSR + (i & 1) * 16384) + lane;
#pragma unroll
            for (int hb = 0; hb < 2; ++hb) {
                f32x4 dk[8], dx[8];
#pragma unroll
                for (int q = 0; q < 8; ++q) { const int b = hb * 2 + (q >> 2), g4 = q & 3;
                    dk[q] = *(const LAS f32x4*)(L + slot + 18432 + (b * 32 + 8 * g4 + 4 * hi) * 4); dx[q] = dd[(b * 4 + g4) * 64]; }
                __builtin_amdgcn_sched_barrier(0);
                asm volatile("s_waitcnt lgkmcnt(0)" ::: "memory");
                __builtin_amdgcn_sched_barrier(0);
#pragma unroll
                for (int q = 0; q < 8; ++q) { const int b = hb * 2 + (q >> 2), g4 = q & 3; const f32x4 d = dk[q], x = dx[q];
                    S[b][4 * g4] = S[b][4 * g4] * d[0] + x[0]; S[b][4 * g4 + 1] = S[b][4 * g4 + 1] * d[1] + x[1]; S[b][4 * g4 + 2] = S[b][4 * g4 + 2] * d[2] + x[2]; S[b][4 * g4 + 3] = S[b][4 * g4 + 3] * d[3] + x[3]; }
            }
            *(volatile LAS unsigned*)w_cons = (unsigned)(i + 1);
            *(volatile LAS unsigned*)w_dsfree = (unsigned)(i + 1);
            if (seen_ofree + 2 <= i) { while ((seen_ofree = (int)lds_poll(w_ofree)) + 2 <= i) __builtin_amdgcn_s_sleep(1); }
            LAS f32x4* od = (LAS f32x4*)(L + HS_ORING + (i & 1) * 4096) + lane;
#pragma unroll
            for (int q = 0; q < 4; ++q) od[q * 64] = (f32x4){o[4 * q] + o2[4 * q], o[4 * q + 1] + o2[4 * q + 1], o[4 * q + 2] + o2[4 * q + 2], o[4 * q + 3] + o2[4 * q + 3]};
            asm volatile("s_waitcnt lgkmcnt(0)" ::: "memory");
            *(volatile LAS unsigned*)w_oready = (unsigned)(i + 1);
        }
        asm volatile("s_waitcnt lgkmcnt(0)" ::: "memory");
    } else {
        int seen = 0;
        for (int i = 0; i < 128; ++i) {
            if (seen <= i) { while ((seen = (int)lds_poll(w_oready)) <= i) __builtin_amdgcn_s_sleep(1); }
            const LAS f32x4* od = (const LAS f32x4*)(L + HS_ORING + (i & 1) * 4096) + lane;
            float o[16];
#pragma unroll
            for (int q = 0; q < 4; ++q) { const f32x4 v = od[q * 64]; o[4 * q] = v[0]; o[4 * q + 1] = v[1]; o[4 * q + 2] = v[2]; o[4 * q + 3] = v[3]; }
            asm volatile("s_waitcnt lgkmcnt(0)" ::: "memory");
            *(volatile LAS unsigned*)w_ofree = (unsigned)(i + 1);
            const int n = dir ? 127 - i : i; const size_t rowb = (size_t)bl * SEQ + (size_t)n * 32;
            if (dir == 0) {
                float* pl = (bl ? OIF1 : OIF0) + ((size_t)n * 32) * DM + h * 128 + vs * 32 + r32;
#pragma unroll
                for (int r = 0; r < 16; ++r) { const int t = (r & 3) + 8 * (r >> 2) + 4 * hi; pl[(size_t)t * DM] = o[r]; }
            } else {
#pragma unroll
                for (int r = 0; r < 16; ++r) { const int t = (r & 3) + 8 * (r >> 2) + 4 * hi; unsafeAtomicAdd(ohg + (rowb + t) * DM + h * 128 + vs * 32 + r32, o[r]); }
            }
        }
        asm volatile("s_waitcnt vmcnt(0) lgkmcnt(0)" ::: "memory");
    }
}

constexpr int AT_VS = 288, AT_LDS = 32 * AT_VS;
DI void attn_mfma_task(const Ctx& C, int task, const bf16_t* projc, bf16_t* attO, float* lse, LAS unsigned char* L) {
    const int lane = C.lane, r32 = lane & 31, hi = lane >> 5;
    const int tb = task & 127, h = (task >> 7) % 12, bl = task / (128 * 12);
    const int g = h >> 2, dsh = (g == 0) ? 0 : (g == 1 ? 2 : 4);
    const int Lc = SEQ >> dsh, bpc = Lc >> 5;
    const int rc = tb / bpc, i0 = (tb % bpc) * 32;
    const size_t base = (size_t)bl * SEQ;
    const float slope_d = exp2f(-8.0f * (float)(h + 1) / 12.0f) * (float)(1 << dsh);
    const bf16_t* qrow = projc + (base + (size_t)(((i0 + r32) << dsh) + rc)) * PJW + C_AQ + h * 128 + 8 * hi;
    bf16x8 qf[8];
#pragma unroll
    for (int ks = 0; ks < 8; ++ks) qf[ks] = *(const bf16x8*)(qrow + ks * 16);
    f32x16 sc[5];
    bf16x8 kf[8], kn[8];
#define AT_KLOAD(dst, kt_) do { int zz_; asm volatile("v_mov_b32 %0, 0" : "=v"(zz_)); int ik_ = i0 - 64 + 32 * (kt_) + r32 + zz_; ik_ = ik_ < 0 ? 0 : (ik_ > Lc - 1 ? Lc - 1 : ik_); \
        const bf16_t* kr_ = projc + (base + (size_t)((ik_ << dsh) + rc)) * PJW + C_AK + h * 128 + 8 * hi; \
        _Pragma("unroll") for (int ks = 0; ks < 8; ++ks) dst[ks] = *(const bf16x8*)(kr_ + ks * 16); } while (0)
    AT_KLOAD(kf, 0);
#pragma unroll
    for (int kt = 0; kt < 5; ++kt) {
        int zk; asm volatile("v_mov_b32 %0, 0" : "=v"(zk));
        if (kt < 4) AT_KLOAD(kn, kt + 1);
        f32x16 a;
#pragma unroll
        for (int r = 0; r < 16; ++r) a[r] = 0.f;
#pragma unroll
        for (int ks = 0; ks < 8; ++ks) a = MFMA32(kf[ks], qf[ks], a);
#pragma unroll
        for (int r = 0; r < 16; ++r) {
            const int kk = 32 * kt - 64 + (r & 3) + 8 * (r >> 2) + 4 * hi + zk, off = kk - r32, ki = i0 + kk;
            const bool valid = (off >= -64) && (off <= 64) && (ki >= 0) && (ki < Lc);
            a[r] = valid ? a[r] - slope_d * (float)(off < 0 ? -off : off) : -1e30f;
        }
        sc[kt] = a;
        if (kt < 4) {
#pragma unroll
            for (int ks = 0; ks < 8; ++ks) kf[ks] = kn[ks];
        }
    }
#undef AT_KLOAD
    float m = -1e30f;
#pragma unroll
    for (int kt = 0; kt < 5; ++kt)
#pragma unroll
        for (int r = 0; r < 16; ++r) m = fmaxf(m, sc[kt][r]);
    m = fmaxf(m, sh32(m, lane));
    float l = 0.f;
#pragma unroll
    for (int kt = 0; kt < 5; ++kt)
#pragma unroll
        for (int r = 0; r < 16; ++r) { sc[kt][r] = __expf(sc[kt][r] - m); l += sc[kt][r]; }
    l += sh32(l, lane);
    const float il = 1.f / l;
#pragma unroll
    for (int kt = 0; kt < 5; ++kt)
#pragma unroll
        for (int r = 0; r < 16; ++r) sc[kt][r] *= il;
    if (hi == 0) lse[(base + (size_t)(((i0 + r32) << dsh) + rc)) * 12 + h] = m + __logf(l);
    f32x16 o[4];
#pragma unroll
    for (int b = 0; b < 4; ++b)
#pragma unroll
        for (int r = 0; r < 16; ++r) o[b][r] = 0.f;
    u32x4 tv[8];
    const int vrow = lane >> 1, vhalf = lane & 1;
#define AT_VLOAD(kt_) do { int zz_; asm volatile("v_mov_b32 %0, 0" : "=v"(zz_)); int ik_ = i0 - 64 + 32 * (kt_) + vrow + zz_; ik_ = ik_ < 0 ? 0 : (ik_ > Lc - 1 ? Lc - 1 : ik_); \
        const bf16_t* vs_ = projc + (base + (size_t)((ik_ << dsh) + rc)) * PJW + C_AV + h * 128 + vhalf * 64; \
        _Pragma("unroll") for (int i = 0; i < 8; ++i) tv[i] = *(const u32x4*)(vs_ + 8 * i); } while (0)
    AT_VLOAD(0);
#pragma unroll
    for (int kt = 0; kt < 5; ++kt) {
#pragma unroll
        for (int i = 0; i < 8; ++i) *(LAS u32x4*)(L + vrow * AT_VS + vhalf * 128 + i * 16) = tv[i];
        if (kt < 4) AT_VLOAD(kt + 1);
        asm volatile("s_waitcnt lgkmcnt(0)" ::: "memory");
#pragma unroll
        for (int sp = 0; sp < 2; ++sp) {
            const bf16x8 A = pack8(sc[kt], sp);
#pragma unroll
            for (int b = 0; b < 4; ++b) {
                bf16x8 B;
#pragma unroll
                for (int j = 0; j < 8; ++j) B[j] = (short)*(const LAS bf16_t*)(L + (16 * sp + 8 * (j >> 2) + 4 * hi + (j & 3)) * AT_VS + (b * 32 + r32) * 2);
                o[b] = MFMA32(A, B, o[b]);
            }
        }
        asm volatile("s_waitcnt lgkmcnt(0)" ::: "memory");
    }
#undef AT_VLOAD
#pragma unroll
    for (int r = 0; r < 16; ++r) {
        const int qi = i0 + (r & 3) + 8 * (r >> 2) + 4 * hi;
        bf16_t* dst = attO + (base + (size_t)((qi << dsh) + rc)) * 1536 + h * 128 + r32;
#pragma unroll
        for (int b = 0; b < 4; ++b) dst[b * 32] = (bf16_t)(cvt_pk_bf16(o[b][r], 0.f) & 0xffffu);
    }
}

DI void fin_task(const Ctx& C, int tl, const float* hnw, const float* OIF0, const float* OIF1, const float* ohg, bf16_t* mixcat, int tok0, const bf16_t* attO, const float* lse) {
    const int lane = C.lane, hh = lane >> 3, v0 = (lane & 7) * 16;
    {
        const int j = lane >> 4, dv0 = (lane & 15) * 8;
        const float l0 = lse[(size_t)tl * 12 + j], l1 = lse[(size_t)tl * 12 + 4 + j], l2 = lse[(size_t)tl * 12 + 8 + j];
        const float mx = fmaxf(l0, fmaxf(l1, l2)); float w0 = __expf(l0 - mx), w1 = __expf(l1 - mx), w2 = __expf(l2 - mx); const float iw = 1.f / (w0 + w1 + w2); w0 *= iw; w1 *= iw; w2 *= iw;
        const bf16_t* ap = attO + (size_t)tl * 1536 + j * 128 + dv0;
        const u32x4 a = *(const u32x4*)ap, b = *(const u32x4*)(ap + 512), c = *(const u32x4*)(ap + 1024);
        u32x4 w;
        w.x = cvt_pk_bf16(w0 * bf_lo(a.x) + w1 * bf_lo(b.x) + w2 * bf_lo(c.x), w0 * bf_hi(a.x) + w1 * bf_hi(b.x) + w2 * bf_hi(c.x));
        w.y = cvt_pk_bf16(w0 * bf_lo(a.y) + w1 * bf_lo(b.y) + w2 * bf_lo(c.y), w0 * bf_hi(a.y) + w1 * bf_hi(b.y) + w2 * bf_hi(c.y));
        w.z = cvt_pk_bf16(w0 * bf_lo(a.z) + w1 * bf_lo(b.z) + w2 * bf_lo(c.z), w0 * bf_hi(a.z) + w1 * bf_hi(b.z) + w2 * bf_hi(c.z));
        w.w = cvt_pk_bf16(w0 * bf_lo(a.w) + w1 * bf_lo(b.w) + w2 * bf_lo(c.w), w0 * bf_hi(a.w) + w1 * bf_hi(b.w) + w2 * bf_hi(c.w));
        *(u32x4*)(mixcat + (size_t)(tok0 + tl) * MCW + 1024 + j * 128 + dv0) = w;
    }
    const float* op = ohg + (size_t)tl * DM + hh * 128 + v0;
    f32x4 o[4]; float ss = 0.f;
    const float* fp = (tl >= SEQ ? OIF1 + (size_t)(tl - SEQ) * DM : OIF0 + (size_t)tl * DM) + hh * 128 + v0;
#pragma unroll
    for (int i = 0; i < 4; ++i) { o[i] = *(const f32x4*)(op + 4 * i) + *(const f32x4*)(fp + 4 * i); ss += o[i].x * o[i].x + o[i].y * o[i].y + o[i].z * o[i].z + o[i].w * o[i].w; }
    ss += SHX(ss, 1); ss += SHX(ss, 2); ss += SHX(ss, 4);
    const float rstd = 1.f / sqrtf(ss * (1.f / 128.f) + RMS_EPS);
    const float* nw = hnw + hh * 128 + v0;
    bf16_t* dst = mixcat + (size_t)(tok0 + tl) * MCW + 1536 + hh * 128 + v0;
    const bf16_t* gp = dst;
#pragma unroll
    for (int i = 0; i < 2; ++i) {
        const u32x4 gv = *(const u32x4*)(gp + 8 * i); const f32x4 n0 = *(const f32x4*)(nw + 8 * i), n1 = *(const f32x4*)(nw + 8 * i + 4);
        const f32x4 a = o[2 * i], b = o[2 * i + 1];
        u32x4 w; w.x = cvt_pk_bf16(a.x * rstd * n0.x * bf_lo(gv.x), a.y * rstd * n0.y * bf_hi(gv.x)); w.y = cvt_pk_bf16(a.z * rstd * n0.z * bf_lo(gv.y), a.w * rstd * n0.w * bf_hi(gv.y));
        w.z = cvt_pk_bf16(b.x * rstd * n1.x * bf_lo(gv.z), b.y * rstd * n1.y * bf_hi(gv.z)); w.w = cvt_pk_bf16(b.z * rstd * n1.z * bf_lo(gv.w), b.w * rstd * n1.w * bf_hi(gv.w));
        *(u32x4*)(dst + 8 * i) = w;
    }
}

#define XB_TMO      128
#define XB_XCNT(j)  (256  + 64 * (j))
#define XB_XSUB(j)  (1280 + 64 * (j))
#define XB_XGEN(j)  (2304 + 64 * (j))
#define XB_TOP      3328
#define XB_TOPGEN   3392
#define XCD_BAR_WORDS 3456
#define XB_SPIN_CAP (1u << 22)
DI unsigned xb_ld(unsigned* p)              { return __hip_atomic_load(p, __ATOMIC_RELAXED, __HIP_MEMORY_SCOPE_AGENT); }
DI unsigned xb_add(unsigned* p, unsigned v) { return __hip_atomic_fetch_add(p, v, __ATOMIC_RELAXED, __HIP_MEMORY_SCOPE_AGENT); }
DI unsigned xb_xcc_id() { return (unsigned)__builtin_amdgcn_s_getreg((3 << 11) | 20) & 0xFu; }
#define XB_SPIN(cond, bar) do { unsigned _sp = 0; while (cond) { __builtin_amdgcn_s_sleep(1); \
    if ((++_sp & 255u) == 0u) { if (xb_ld(&(bar)[XB_TMO])) break; if (_sp > XB_SPIN_CAP) { atomicAdd(&(bar)[XB_TMO], 1u); break; } } } } while (0)
DI void xcd_barrier_complete(unsigned* bar, unsigned x, unsigned& nloc, unsigned& nx) {
    const unsigned G = gridDim.x * gridDim.y * gridDim.z;
    unsigned sum, cnt, mine, sp = 0u;
    for (;;) {
        sum = 0u; cnt = 0u; mine = 0u;
#pragma unroll
        for (unsigned j = 0; j < 16; ++j) { const unsigned c = xb_ld(&bar[XB_XCNT(j)]); sum += c; cnt += (c > 0u) ? 1u : 0u; mine = (j == x) ? c : mine; }
        if (sum == G) break;
        __builtin_amdgcn_s_sleep(1);
        if ((++sp & 255u) == 0u) { if (xb_ld(&bar[XB_TMO])) break; if (sp > XB_SPIN_CAP) { atomicAdd(&bar[XB_TMO], 1u); break; } }
    }
    nloc = mine > 0u ? mine : 1u; nx = cnt > 0u ? cnt : 1u;
}
DI void xcd_barrier(unsigned* bar, unsigned x, volatile LAS unsigned* st, bool is_t0) {
    asm volatile("s_waitcnt vmcnt(0)" ::: "memory");
    __syncthreads();
    if (is_t0) {
        __builtin_amdgcn_s_waitcnt(0);
        unsigned nloc = st[0], nx = st[1];
        if (nloc == 0u) { xcd_barrier_complete(bar, x, nloc, nx); st[0] = nloc; st[1] = nx; }
        const unsigned old = xb_add(&bar[XB_XSUB(x)], 1u);
        const unsigned gen = old / nloc;
        if (old + 1u == (gen + 1u) * nloc) {
            __builtin_amdgcn_fence(__ATOMIC_RELEASE, "agent");
            asm volatile("s_waitcnt vmcnt(0)" ::: "memory");
            const unsigned og = xb_add(&bar[XB_TOP], 1u);
            const unsigned tg = og / nx;
            if (og + 1u == (tg + 1u) * nx) xb_add(&bar[XB_TOPGEN], 1u);
            else XB_SPIN(xb_ld(&bar[XB_TOPGEN]) == tg, bar);
            __builtin_amdgcn_fence(__ATOMIC_ACQUIRE, "agent");
            xb_add(&bar[XB_XGEN(x)], 1u);
            asm volatile("s_waitcnt vmcnt(0)" ::: "memory");
        } else {
            XB_SPIN(xb_ld(&bar[XB_XGEN(x)]) == gen, bar);
            __builtin_amdgcn_fence(__ATOMIC_ACQUIRE, "agent");
            asm volatile("s_waitcnt vmcnt(0)" ::: "memory");
        }
    }
    __syncthreads();
}

constexpr int NMIX = 3 * NCH + 1;
constexpr int PH_PER_LAYER = NMIX + 6, NPH = 1 + DEPTH * PH_PER_LAYER;

__global__ void __launch_bounds__(512, 2) mega(Args args) {
    extern __shared__ __attribute__((aligned(16))) unsigned char lds_raw[];
    cg::grid_group grid = cg::this_grid();
    const int wave_s = __builtin_amdgcn_readfirstlane(threadIdx.x >> 6);
    volatile LAS unsigned* xb_st = (volatile LAS unsigned*)((LAS unsigned char*)lds_raw + LDS_BYTES - 64);
    unsigned* xb_bar = (unsigned*)(args.ws + WS_BAR);
    const unsigned xb_x = xb_xcc_id();
    const bool xb_t0 = (threadIdx.x == 0);
    if (xb_t0) { xb_st[0] = 0u; xb_st[1] = 0u; (void)xb_add(&xb_bar[XB_XCNT(xb_x)], 1u); }
    __syncthreads();
    for (int ph = args.ph_lo; ph < args.ph_hi; ++ph) {
        if (ph > args.ph_lo) {
            asm volatile("s_waitcnt vmcnt(0) lgkmcnt(0)" ::: "memory");
            if (ph == args.ph_lo + 1) {
                grid.sync();
                if (wave_s == 0) { __builtin_amdgcn_fence(__ATOMIC_ACQUIRE, "agent"); asm volatile("s_waitcnt vmcnt(0)" ::: "memory"); }
                __builtin_amdgcn_s_barrier(); asm volatile("" ::: "memory");
            } else xcd_barrier(xb_bar, xb_x, xb_st, xb_t0);
        }
        int z, zv; asm volatile("s_mov_b32 %0, 0" : "=s"(z)); asm volatile("v_mov_b32 %0, 0" : "=v"(zv));
        Ctx C; C.lds = (LAS unsigned char*)lds_raw; { int ln; asm volatile("v_mbcnt_lo_u32_b32 %0, -1, 0\n\tv_mbcnt_hi_u32_b32 %0, -1, %0" : "=&v"(ln)); C.lane = ln; } C.wave = wave_s + z; C.tid = C.wave * 64 + C.lane;
        const int bid = blockIdx.x + z; const float fz = __int_as_float(zv);
        C.G = gridDim.x + z; C.gw = bid * 8 + C.wave; C.NGW = C.G * 8;
        unsigned char* ws = args.ws + (size_t)z;
        float* lbv = (float*)(ws + WS_LB);
        bf16_t* WinT = (bf16_t*)(ws + WS_WIN); bf16_t* WcatT = (bf16_t*)(ws + WS_WCAT); bf16_t* WoutT = (bf16_t*)(ws + WS_WOUT); bf16_t* WguT = (bf16_t*)(ws + WS_WGU); bf16_t* WdpT = (bf16_t*)(ws + WS_WDP);
        bf16_t* Xbf = (bf16_t*)(ws + WS_XBF); bf16_t* mixcat = (bf16_t*)(ws + WS_MIXCAT); bf16_t* gates = (bf16_t*)(ws + WS_GATES); bf16_t* projc = (bf16_t*)(ws + WS_PROJC);
        float* logf = (float*)(ws + WS_LOGF); float* ohg = (float*)(ws + WS_OHG); bf16_t* merged = (bf16_t*)(ws + WS_MERGED); bf16_t* hidden = (bf16_t*)(ws + WS_HIDDEN); bf16_t* pgb = (bf16_t*)(ws + WS_PG); bf16_t* attO = (bf16_t*)(ws + WS_ATTO); float* lsev = (float*)(ws + WS_LSE);
        float* OIF1 = (float*)(ws + WS_OIF1); u32x4* QF = (u32x4*)(ws + WS_QF); u32x4* KF = (u32x4*)(ws + WS_KF); u32x4* VF = (u32x4*)(ws + WS_VF); float* DCb = (float*)(ws + WS_DC);
        float* X = args.out;

        if (ph == 0) {
            for (int jx = bid * 512 + C.tid; jx < 2048; jx += C.G * 512) {
                const float* L = args.in[I_LBL + z];
                const float x0 = L[jx], x1 = L[2048 + jx], x2 = L[4096 + jx], x3 = L[6144 + jx];
                const float mx = fmaxf(fmaxf(x0, x1), fmaxf(x2, x3));
                const float e0 = expf(x0 - mx), e1 = expf(x1 - mx), e2 = expf(x2 - mx), e3 = expf(x3 - mx), inv = 1.f / (e0 + e1 + e2 + e3);
                lbv[jx] = 0.f; lbv[2048 + jx] = e1 * inv; lbv[4096 + jx] = (e1 + e2) * inv; lbv[6144 + jx] = (e1 + e2 + e3) * inv;
            }
            conv_weights(C, args, z, 0);
            const float* x = args.in[I_X + z];
            {
                const size_t stride = (size_t)C.G * 512, nitem = (size_t)T * DM / 8;
                size_t i = (size_t)bid * 512 + C.tid;
                for (; i + 3 * stride < nitem; i += 4 * stride) {
                    f32x4 a[4], b[4];
#pragma unroll
                    for (int q = 0; q < 4; ++q) { a[q] = *(const f32x4*)(x + (i + q * stride) * 8); b[q] = *(const f32x4*)(x + (i + q * stride) * 8 + 4); }
#pragma unroll
                    for (int q = 0; q < 4; ++q) { u32x4 w; w.x = cvt_pk_bf16(a[q].x, a[q].y); w.y = cvt_pk_bf16(a[q].z, a[q].w); w.z = cvt_pk_bf16(b[q].x, b[q].y); w.w = cvt_pk_bf16(b[q].z, b[q].w);
                        *(u32x4*)(Xbf + (i + q * stride) * 8) = w; }
                }
                for (; i < nitem; i += stride) {
                    const f32x4 a = *(const f32x4*)(x + i * 8), b = *(const f32x4*)(x + i * 8 + 4);
                    u32x4 w; w.x = cvt_pk_bf16(a.x, a.y); w.y = cvt_pk_bf16(a.z, a.w); w.z = cvt_pk_bf16(b.x, b.y); w.w = cvt_pk_bf16(b.z, b.w);
                    *(u32x4*)(Xbf + i * 8) = w;
                }
            }
            continue;
        }
        const int layer = (ph - 1) / PH_PER_LAYER, r = (ph - 1) % PH_PER_LAYER;
        if (r < NMIX) {
            const int ch = r < 3 * NCH ? r / 3 : NCH - 1, sub = r < 3 * NCH ? r % 3 : 3, tok0 = ch * TC;
            if (sub == 0) {
                if (ch > 0) { const float* hnw = args.in[I_HNW + z] + (size_t)layer * DM;
                    for (int tl = C.gw; tl < TC; tl += C.NGW) fin_task(C, tl, hnw, (const float*)Xbf, OIF1, ohg, mixcat, tok0 - TC, attO, lsev); }
                pg8::Gemm g{Xbf + (size_t)tok0 * DM, WinT, DM, DM};
                typedef pg8::SegSched<1, 0, 0, 0, 16, 16, 16> SS; SS S; S.o.init(TC / 256, INW / 256, C.G, bid);
                EpiProj E{projc, logf, gates, lbv + layer * 2048, tok0, mixcat};
                pg8::gemm_phase<EpiProj, SS>(C.lds, C.tid, fz, g, S, E);
            } else if (sub == 1) {
                if (C.wave < 4) {
                    LAS unsigned char* scr = C.lds + C.wave * HP_LDS;
                    for (int t = bid * 4 + C.wave; t < 2 * 8 * 128; t += C.G * 4) hgrn_prep_task(C, t, projc, logf, ohg, QF, KF, VF, DCb, scr);
                } else {
                    for (int wt = bid * 4 + (C.wave - 4); wt < TC * 2; wt += C.G * 4) pool_task(C, wt, projc, mixcat, tok0);
                }
            } else if (sub == 2) {
                if (C.tid < 8) *(volatile LAS unsigned*)(C.lds + HS_CTL + 64 * C.tid) = 0u;
                asm volatile("s_waitcnt lgkmcnt(0)" ::: "memory"); __builtin_amdgcn_s_barrier(); asm volatile("" ::: "memory");
                const bool scan_wg = bid < 128;
                if (scan_wg && C.wave < 4) hgrn_scan_role(C, C.wave, bid, QF, KF, VF, DCb, ohg, (float*)Xbf, OIF1, C.lds);
                else if (!scan_wg) {
                    const int nscan = C.G < 128 ? C.G : 128;
                    LAS unsigned char* scr = C.lds + C.wave * 10240;
                    const int w = (bid - nscan) * 8 + C.wave, nw = (C.G - nscan) * 8;
                    for (int wt = w; wt < 2 * 12 * 128; wt += nw) attn_mfma_task(C, wt, projc, attO, lsev, scr);
                }
            } else {
                const float* hnw = args.in[I_HNW + z] + (size_t)layer * DM;
                for (int tl = C.gw; tl < TC; tl += C.NGW) fin_task(C, tl, hnw, (const float*)Xbf, OIF1, ohg, mixcat, tok0, attO, lsev);
            }
        } else if (r == NMIX) {
            pg8::Gemm g{mixcat, WcatT, MCW, MCW};
            typedef pg8::SegSched<3, 0, 1024, 1536, 16, 8, 16> SS; SS S; S.o.init(T / 256, DM / 256, C.G, bid);
            EpiMerge E{gates, merged};
            pg8::gemm_phase<EpiMerge, SS>(C.lds, C.tid, fz, g, S, E);
        } else if (r == NMIX + 1) {
            pg8::Gemm g{merged, WoutT, DM, DM};
            typedef pg8::SegSched<1, 0, 0, 0, 16, 16, 16> SS; SS S; S.o.init(T / 256, DM / 256, C.G, bid);
            EpiOut E{layer == 0 ? args.in[I_X + z] : (const float*)X, X};
            pg8::gemm_phase<EpiOut, SS>(C.lds, C.tid, fz, g, S, E);
        } else if (r == NMIX + 2) {
            const float* g1 = args.in[I_LN1G + z] + layer * DM; const float* b1 = args.in[I_LN1B + z] + layer * DM;
            const float* p = args.in[I_P + z] + (size_t)layer * T * PLE;
            for (int row = C.gw * 4; row < T; row += C.NGW * 4) {
                ln_rows<4>(X + (size_t)row * DM, Xbf + (size_t)row * DM, g1, b1, C.lane);
#pragma unroll
                for (int q = 0; q < 4; ++q) {
                    const f32x4 pv = *((const f32x4*)(p + (size_t)(row + q) * PLE) + C.lane);
                    u32x2 w; w.x = cvt_pk_bf16(pv.x, pv.y); w.y = cvt_pk_bf16(pv.z, pv.w);
                    *((u32x2*)(hidden + (size_t)(row + q) * HDW + FFH) + C.lane) = w;
                }
            }
        } else if (r == NMIX + 3) {
            pg8::Gemm g{Xbf, WguT, DM, DM};
            typedef pg8::SegSched<1, 0, 0, 0, 16, 16, 16> SS; SS S; S.o.init(T / 256, 6656 / 256, C.G, bid);
            EpiFfn E{hidden, pgb};
            pg8::gemm_phase<EpiFfn, SS>(C.lds, C.tid, fz, g, S, E);
        } else if (r == NMIX + 4) {
            pg8::Gemm g{hidden, WdpT, HDW, HDW};
            typedef pg8::SegSched<2, FFH, 0, 0, 4, 44, 44> SS; SS S; S.o.init(T / 256, DM / 256, C.G, bid);
            EpiDown E{pgb, X};
            pg8::gemm_phase<EpiDown, SS>(C.lds, C.tid, fz, g, S, E);
        } else {
            const float* g2 = args.in[I_LN2G + z] + layer * DM; const float* b2 = args.in[I_LN2B + z] + layer * DM;
            for (int row = C.gw * 4; row < T; row += C.NGW * 4) ln_rows<4>(X + (size_t)row * DM, Xbf + (size_t)row * DM, g2, b2, C.lane);
            if (layer + 1 < DEPTH) conv_weights(C, args, z, layer + 1);
        }
    }
}

extern "C" void kernel_launch(void* const* d_in, const int* in_sizes, int n_in, void* d_out, int out_size, void* d_ws, size_t ws_size, hipStream_t stream) {
    static int grid = 0;
    if (grid == 0) {
        if (n_in != 20 || out_size != T * DM || ws_size < WS_END) { fprintf(stderr, "kernel_launch: unexpected problem (n_in %d out %d ws %zu)\n", n_in, out_size, ws_size); grid = -1; return; }
        int dev = 0, cus = 0, per_cu = 0;
        hipGetDevice(&dev); hipDeviceGetAttribute(&cus, hipDeviceAttributeMultiprocessorCount, dev);
        hipFuncSetAttribute((const void*)mega, hipFuncAttributeMaxDynamicSharedMemorySize, LDS_BYTES);
        hipOccupancyMaxActiveBlocksPerMultiprocessor(&per_cu, (const void*)mega, 512, LDS_BYTES);
        if (per_cu < 1) { fprintf(stderr, "kernel_launch: occupancy query says %d\n", per_cu); per_cu = 1; }
        (void)hipGetLastError();
        grid = cus * 1;
    }
    if (grid < 0) return;
    (void)hipMemsetAsync((char*)d_ws + WS_BAR, 0, XCD_BAR_WORDS * 4, stream);
    Args a{};
    for (int i = 0; i < 20; ++i) a.in[i] = (const float*)d_in[i];
    a.out = (float*)d_out; a.ws = (unsigned char*)d_ws;
#if MK_MULTI
    for (int ph = 0; ph < NPH; ++ph) { a.ph_lo = ph; a.ph_hi = ph + 1; void* kargs[] = {&a};
        hipError_t e = hipLaunchCooperativeKernel((const void*)mega, dim3(grid), dim3(512), kargs, LDS_BYTES, stream);
        if (e != hipSuccess) { fprintf(stderr, "launch %d failed: %s\n", ph, hipGetErrorString(e)); break; } }
#else
    a.ph_lo = 0; a.ph_hi = NPH; void* kargs[] = {&a};
    hipError_t e = hipLaunchCooperativeKernel((const void*)mega, dim3(grid), dim3(512), kargs, LDS_BYTES, stream);
    if (e != hipSuccess) fprintf(stderr, "cooperative launch failed: %s (grid %d)\n", hipGetErrorString(e), grid);
#endif
}
```

```cpp
#include <hip/hip_runtime.h>
#include <hip/hip_cooperative_groups.h>
#include <cstdio>
#include <cstdint>
namespace cg = cooperative_groups;

#ifndef MK_MULTI
#define MK_MULTI 0
#endif

#ifndef DBG_NPH
#define DBG_NPH 0
#endif
#ifndef DBG_OFF
#define DBG_OFF 0
#endif
constexpr int DM = 1024, NBATCH = 8, SEQ = 4096, DEPTH = 4, T = NBATCH * SEQ;
constexpr int PLE = 256, FFH = 2816, INW = 13824;
constexpr int NCH = 4, TC = T / NCH;
constexpr int C_POOL = 0, C_AQ = 1024, C_AK = 2560, C_AV = 4096, C_HQ = 5632, C_HI = 6656, C_HFF = 7680, C_HFB = 8704, C_HG = 9728, C_GATE = 10752;
constexpr int PJW = 10752;
constexpr int MCW = 2560;
constexpr int HDW = 3072;
constexpr float ALPHA = 1.681792830507429f;
constexpr float LN_EPS = 1e-5f, RMS_EPS = 1e-6f;

constexpr size_t MiB = 1u << 20;
constexpr size_t WS_LB = 0, WS_BAR = 512 * 1024;
constexpr size_t WS_WIN = 1 * MiB, WS_WCAT = 28 * MiB, WS_WOUT = 33 * MiB, WS_WGU = 35 * MiB, WS_WDP = 48 * MiB;
constexpr size_t WS_XBF = 54 * MiB, WS_MIXCAT = 118 * MiB, WS_GATES = 278 * MiB, WS_PROJC = 470 * MiB, WS_LOGF = 638 * MiB, WS_OHG = 702 * MiB, WS_ATTO = 798 * MiB, WS_LSE = 822 * MiB, WS_VF = 823 * MiB, WS_DC = 839 * MiB, WS_OIF1 = 843 * MiB, WS_END = 859 * MiB;
constexpr size_t WS_QF = 734 * MiB, WS_KF = 766 * MiB;
constexpr size_t WS_MERGED = WS_PROJC, WS_HIDDEN = WS_MIXCAT, WS_PG = 734 * MiB;
constexpr int LDS_BYTES = 147456;

typedef unsigned short bf16_t;
typedef short bf16x8 __attribute__((ext_vector_type(8)));
typedef float f32x4 __attribute__((ext_vector_type(4)));
typedef float f32x2 __attribute__((ext_vector_type(2)));
typedef unsigned u32x4 __attribute__((ext_vector_type(4)));
typedef unsigned u32x2 __attribute__((ext_vector_type(2)));
#define LAS __attribute__((address_space(3)))
#define DI __device__ __forceinline__

typedef __bf16 bf16x2_t __attribute__((ext_vector_type(2)));
DI unsigned cvt_pk_bf16(float lo, float hi) { f32x2 v = {lo, hi}; bf16x2_t b = __builtin_convertvector(v, bf16x2_t); return __builtin_bit_cast(unsigned, b); }
DI float bf_lo(unsigned u) { return __uint_as_float(u << 16); }
DI float bf_hi(unsigned u) { return __uint_as_float(u & 0xffff0000u); }
DI float bf1(bf16_t u) { return __uint_as_float(((unsigned)u) << 16); }
DI float sigmoidf_(float x) { return __builtin_amdgcn_rcpf(1.f + __expf(-x)); }
DI float siluf_(float x) { return x * sigmoidf_(x); }
#define SHX(v, k) __int_as_float(__builtin_amdgcn_ds_swizzle(__float_as_int(v), 0x1f | ((k) << 10)))
DI float sh32(float v, int lane) { return __int_as_float(__builtin_amdgcn_ds_bpermute((lane ^ 32) << 2, __float_as_int(v))); }
DI float wave_sum(float v, int lane) { v += SHX(v, 1); v += SHX(v, 2); v += SHX(v, 4); v += SHX(v, 8); v += SHX(v, 16); v += sh32(v, lane); return v; }

namespace pg8 {
constexpr int BM = 256, BK = 64, HALF = 128, HTB = HALF * BK * 2, STAGE_BYTES = 8 * HTB, NXCD = 8, WGM = 8;
__host__ __device__ __forceinline__ int lds_byte(int r, int c) { const int st = (r >> 4) * 2 + (c >> 5), rr = r & 15, cc = c & 31, ob = rr * 64 + cc * 2; return st * 1024 + (ob ^ (((ob >> 9) & 1) << 5)); }
__host__ __device__ __forceinline__ void stage_rc(int b, int& R, int& C) { const int st = b / 1024, sb = b % 1024, swz = sb ^ (((sb >> 9) & 1) << 5); R = (st >> 1) * 16 + swz / 64; C = (st & 1) * 32 + (swz % 64) / 2; }
__host__ __device__ __forceinline__ int perm32(int rho) { const int n = rho >> 4, i = rho & 15; return 8 * (i >> 2) + 4 * n + (i & 3); }

struct Unit { int pm, pn, koff, nt, seg; };
struct Gemm { const bf16_t* A; const bf16_t* Bt; int lda, ldb; };

struct TileOrder {
    int nM, nN, nwg, G, c;
    DI void init(int nM_, int nN_, int G_, int c_) { nM = nM_; nN = nN_; nwg = nM * nN; G = G_; c = c_; }
    DI bool tile(int i, int& pm, int& pn) const {
        const long L = (long)i * G + c; if (L >= nwg) return false;
        int wgid = (int)L; { const int q = nwg / NXCD, r = nwg % NXCD, xcd = wgid % NXCD, off = wgid / NXCD; wgid = (xcd < r ? xcd * (q + 1) : r * (q + 1) + (xcd - r) * q) + off; }
        const int nig = WGM * nN, gid = wgid / nig, fm = gid * WGM, gsz = (nM - fm) < WGM ? (nM - fm) : WGM;
        pm = fm + ((wgid % nig) % gsz); pn = (wgid % nig) / gsz; return true;
    }
};
template <int NSEG, int K0, int K1, int K2, int N0, int N1, int N2>
struct SegSched {
    TileOrder o;
    DI bool next(int i, Unit& u) const {
        const int round = i / NSEG, s = i - round * NSEG;
        if (!o.tile(round, u.pm, u.pn)) return false;
        u.seg = s; u.koff = (s == 0) ? K0 : (s == 1 ? K1 : K2); u.nt = (s == 0) ? N0 : (s == 1 ? N1 : N2); return true;
    }
};

template <class Epi, class Sched>
DI void gemm_phase(LAS unsigned char* lds, const int tid, const float fz, const Gemm g, const Sched S, const Epi E) {
    const int wid = __builtin_amdgcn_readfirstlane(tid >> 6), lane = tid & 63, wr = wid >> 2, wc = wid & 3, fr = lane & 15, fq = lane >> 4;
    unsigned voffA[2], voffB[2];
#pragma unroll
    for (int i = 0; i < 2; ++i) { int R, C; stage_rc(tid * 16 + i * 8192, R, C); const int Rb = Epi::PERM ? ((R & ~31) + perm32(R & 31)) : R;
        voffA[i] = (unsigned)(R * g.lda + C) * 2u; voffB[i] = (unsigned)(Rb * g.ldb + C) * 2u; }
    const size_t kstep = (size_t)(BK * 2);
    const size_t hstepA = (size_t)HALF * g.lda * 2, hstepB = (size_t)HALF * g.ldb * 2;
    const size_t tstepA = 2 * hstepA, tstepB = 2 * hstepB;
    const unsigned ldsw = (unsigned)wid * 1024u;
    const int aoff = lds_byte(wr * 64 + fr, fq * 8), boff = lds_byte(wc * 32 + fr, fq * 8);
#define PG8_SA(b, h) (((b) * 2 + (h)) * HTB)
#define PG8_SB(b, h) ((4 + (b) * 2 + (h)) * HTB)
#define PG8_STAGE(bufoff, gbase, voff) do { _Pragma("unroll") for (int _i = 0; _i < 2; ++_i) \
        __builtin_amdgcn_global_load_lds((const unsigned*)((const char*)(gbase) + (voff)[_i]), (LAS unsigned*)(lds + (bufoff) + ldsw + _i * 8192), 16, 0, 0); } while (0)
#define PG8_LDA(dst, b, h) do { _Pragma("unroll") for (int m = 0; m < 4; ++m) _Pragma("unroll") for (int k = 0; k < 2; ++k) dst[m][k] = *(const LAS bf16x8*)(lds + PG8_SA(b, h) + aoff + m * 2048 + k * 1024); } while (0)
#define PG8_LDB(dst, b, h) do { _Pragma("unroll") for (int n = 0; n < 2; ++n) _Pragma("unroll") for (int k = 0; k < 2; ++k) dst[n][k] = *(const LAS bf16x8*)(lds + PG8_SB(b, h) + boff + n * 2048 + k * 1024); } while (0)
#define PG8_MMA(ai, bj, At, Bt) do { __builtin_amdgcn_s_setprio(1); _Pragma("unroll") for (int m = 0; m < 4; ++m) _Pragma("unroll") for (int n = 0; n < 2; ++n) _Pragma("unroll") for (int k = 0; k < 2; ++k) \
        acc[ai][bj][m][n] = __builtin_amdgcn_mfma_f32_16x16x32_bf16(Bt[n][k], At[m][k], acc[ai][bj][m][n], 0, 0, 0); __builtin_amdgcn_s_setprio(0); } while (0)
#define PG8_WAIT_V(n) asm volatile("s_waitcnt vmcnt(" #n ")" ::: "memory")
#define PG8_WAIT_L(n) asm volatile("s_waitcnt lgkmcnt(" #n ")" ::: "memory")
#define PG8_BAR __builtin_amdgcn_s_barrier()
#define PG8_SCHED __builtin_amdgcn_sched_barrier(0)
    Unit cur, nxt; int ui = 0;
    asm volatile("s_waitcnt vmcnt(0)" ::: "memory");
    if (!S.next(0, cur)) return;
    f32x4 acc[2][2][4][2];
#pragma unroll
    for (int a = 0; a < 2; ++a)
#pragma unroll
        for (int b = 0; b < 2; ++b)
#pragma unroll
            for (int m = 0; m < 4; ++m)
#pragma unroll
                for (int n = 0; n < 2; ++n) acc[a][b][m][n] = (f32x4){fz, fz, fz, fz};
    bf16x8 At[4][2], B0[2][2], B1[2][2];
    const char* cA = (const char*)g.A + (size_t)cur.pm * tstepA + (size_t)cur.koff * 2; const char* cB = (const char*)g.Bt + (size_t)cur.pn * tstepB + (size_t)cur.koff * 2;
    PG8_STAGE(PG8_SB(0, 0), cB, voffB); PG8_STAGE(PG8_SB(0, 1), cB + hstepB, voffB); PG8_STAGE(PG8_SA(0, 0), cA, voffA); PG8_STAGE(PG8_SA(0, 1), cA + hstepA, voffA);
    if (wr == 1) PG8_BAR;
    PG8_WAIT_V(2); PG8_BAR;
    PG8_STAGE(PG8_SB(1, 0), cB + kstep, voffB); PG8_STAGE(PG8_SA(1, 0), cA + kstep, voffA); PG8_STAGE(PG8_SB(1, 1), cB + hstepB + kstep, voffB);
    PG8_WAIT_V(6); PG8_BAR;
    for (;;) {
        const bool has_next = S.next(ui + 1, nxt);
        const char* nA = has_next ? (const char*)g.A + (size_t)nxt.pm * tstepA + (size_t)nxt.koff * 2 : cA; const char* nB = has_next ? (const char*)g.Bt + (size_t)nxt.pn * tstepB + (size_t)nxt.koff * 2 : cB;
        const int nt = cur.nt;
        for (int t = 0; t < nt; t += 2) {
            const bool last = (t == nt - 2);
            const char* a1 = cA + (size_t)(t + 1) * kstep;
            const char* a2 = last ? nA : cA + (size_t)(t + 2) * kstep; const char* b2 = last ? nB : cB + (size_t)(t + 2) * kstep;
            const char* a3 = a2 + kstep; const char* b3 = b2 + kstep;
            PG8_LDB(B0, 0, 0); PG8_LDB(B1, 0, 1); PG8_SCHED; PG8_LDA(At, 0, 0); PG8_STAGE(PG8_SA(1, 1), a1 + hstepA, voffA);
            PG8_WAIT_V(8); PG8_WAIT_L(0); PG8_BAR; PG8_MMA(0, 0, At, B0); PG8_MMA(0, 1, At, B1); PG8_BAR; PG8_SCHED;
            PG8_LDA(At, 0, 1); PG8_STAGE(PG8_SB(0, 0), b2, voffB); PG8_STAGE(PG8_SB(0, 1), b2 + hstepB, voffB); PG8_STAGE(PG8_SA(0, 0), a2, voffA);
            PG8_WAIT_V(8); PG8_WAIT_L(0); PG8_BAR; PG8_MMA(1, 0, At, B0); PG8_MMA(1, 1, At, B1); PG8_BAR; PG8_SCHED;
            PG8_LDB(B0, 1, 0); PG8_LDB(B1, 1, 1); PG8_SCHED; PG8_LDA(At, 1, 0); PG8_STAGE(PG8_SA(0, 1), a2 + hstepA, voffA);
            PG8_WAIT_V(8); PG8_WAIT_L(0); PG8_BAR; PG8_MMA(0, 0, At, B0); PG8_MMA(0, 1, At, B1); PG8_BAR; PG8_SCHED;
            PG8_LDA(At, 1, 1); PG8_STAGE(PG8_SB(1, 0), b3, voffB); PG8_STAGE(PG8_SB(1, 1), b3 + hstepB, voffB); PG8_STAGE(PG8_SA(1, 0), a3, voffA);
            PG8_WAIT_V(8); PG8_WAIT_L(0); PG8_BAR; PG8_MMA(1, 0, At, B0); PG8_MMA(1, 1, At, B1); PG8_BAR; PG8_SCHED;
        }
        if (wr == 0) PG8_BAR;
        const bool keep = E(acc, cur, wr, wc, fr, fq);
        if (!has_next) break;
        if (!keep) {
#pragma unroll
            for (int a = 0; a < 2; ++a)
#pragma unroll
                for (int b = 0; b < 2; ++b)
#pragma unroll
                    for (int m = 0; m < 4; ++m)
#pragma unroll
                        for (int n = 0; n < 2; ++n) acc[a][b][m][n] = (f32x4){fz, fz, fz, fz};
        }
        cur = nxt; cA = nA; cB = nB; ++ui;
        if (wr == 1) PG8_BAR;
    }
    PG8_WAIT_V(0);
    PG8_BAR;
#undef PG8_SA
#undef PG8_SB
#undef PG8_STAGE
#undef PG8_LDA
#undef PG8_LDB
#undef PG8_MMA
#undef PG8_WAIT_V
#undef PG8_WAIT_L
#undef PG8_BAR
#undef PG8_SCHED
}
}
using pg8::Unit;

struct EpiProj {
    static constexpr bool PERM = true;
    bf16_t* projc; float* logf; bf16_t* gates; const float* lb; int tok0; bf16_t* mixcat;
    DI bool operator()(f32x4 (&acc)[2][2][4][2], const Unit& u, int wr, int wc, int fr, int fq) const {
        const int row0 = u.pm * 256 + wr * 64 + fr;
        const int pn = u.pn;
        int kind;
        if (pn < 4) kind = 0; else if (pn < 10) kind = 1; else if (pn < 22) kind = 0; else if (pn < 26) kind = 2; else if (pn < 30) kind = 0;
        else if (pn < 38) kind = 3; else if (pn < 42) kind = 2; else kind = 4;
#pragma unroll
        for (int ai = 0; ai < 2; ++ai)
#pragma unroll
            for (int m = 0; m < 4; ++m) {
                const int row = row0 + ai * 128 + m * 16;
#pragma unroll
                for (int bj = 0; bj < 2; ++bj) {
                    const int col = pn * 256 + bj * 128 + wc * 32 + 8 * fq;
                    f32x4 v0 = acc[ai][bj][m][0], v1 = acc[ai][bj][m][1];
                    if (kind == 1) { v0 = v0 * 0.08838834764831845f; v1 = v1 * 0.08838834764831845f; }
                    else if (kind == 2) {
#pragma unroll
                        for (int e = 0; e < 4; ++e) { v0[e] = siluf_(v0[e]); v1[e] = siluf_(v1[e]); }
                    } else if (kind == 4) {
#pragma unroll
                        for (int e = 0; e < 4; ++e) { v0[e] = fmaxf(sigmoidf_(v0[e]), 1e-7f); v1[e] = fmaxf(sigmoidf_(v1[e]), 1e-7f); }
                    } else if (kind == 3) {
                        const int li = col - C_HFF;
                        const f32x4 l0 = *(const f32x4*)(lb + li), l1 = *(const f32x4*)(lb + li + 4);
                        f32x4 lf0, lf1;
#pragma unroll
                        for (int e = 0; e < 4; ++e) {
                            const float s0 = sigmoidf_(v0[e]), s1 = sigmoidf_(v1[e]);
                            lf0[e] = __logf(l0[e] + (1.f - l0[e]) * s0); lf1[e] = __logf(l1[e] + (1.f - l1[e]) * s1);
                            v0[e] = (1.f - l0[e]) * (1.f - s0); v1[e] = (1.f - l1[e]) * (1.f - s1);
                        }
                        float* lp = logf + (size_t)row * 2048 + li;
                        *(f32x4*)lp = lf0; *(f32x4*)(lp + 4) = lf1;
                    }
                    u32x4 w; w.x = cvt_pk_bf16(v0[0], v0[1]); w.y = cvt_pk_bf16(v0[2], v0[3]); w.z = cvt_pk_bf16(v1[0], v1[1]); w.w = cvt_pk_bf16(v1[2], v1[3]);
                    if (kind == 4) *(u32x4*)(gates + (size_t)(tok0 + row) * 3072 + (col - C_GATE)) = w;
                    else if (pn >= 38) *(u32x4*)(mixcat + (size_t)(tok0 + row) * MCW + 1536 + (col - C_HG)) = w;
                    else *(u32x4*)(projc + (size_t)row * PJW + col) = w;
                }
            }
        return false;
    }
};
struct EpiMerge {
    static constexpr bool PERM = true;
    const bf16_t* gates; bf16_t* merged;
    DI bool operator()(f32x4 (&acc)[2][2][4][2], const Unit& u, int wr, int wc, int fr, int fq) const {
        const int row0 = u.pm * 256 + wr * 64 + fr;
#pragma unroll
        for (int ai = 0; ai < 2; ++ai)
#pragma unroll
            for (int m = 0; m < 4; ++m) {
                const int row = row0 + ai * 128 + m * 16;
#pragma unroll
                for (int bj = 0; bj < 2; ++bj) {
                    const int col = u.pn * 256 + bj * 128 + wc * 32 + 8 * fq;
                    const bf16_t* gp = gates + (size_t)row * 3072 + col;
                    f32x4& v0 = acc[ai][bj][m][0]; f32x4& v1 = acc[ai][bj][m][1];
                    if (u.seg < 2) {
                        const u32x4 gn = *(const u32x4*)(gp + u.seg * 1024), gd = *(const u32x4*)(gp + (u.seg + 1) * 1024);
                        v0[0] *= bf_lo(gn.x) * __builtin_amdgcn_rcpf(bf_lo(gd.x)); v0[1] *= bf_hi(gn.x) * __builtin_amdgcn_rcpf(bf_hi(gd.x));
                        v0[2] *= bf_lo(gn.y) * __builtin_amdgcn_rcpf(bf_lo(gd.y)); v0[3] *= bf_hi(gn.y) * __builtin_amdgcn_rcpf(bf_hi(gd.y));
                        v1[0] *= bf_lo(gn.z) * __builtin_amdgcn_rcpf(bf_lo(gd.z)); v1[1] *= bf_hi(gn.z) * __builtin_amdgcn_rcpf(bf_hi(gd.z));
                        v1[2] *= bf_lo(gn.w) * __builtin_amdgcn_rcpf(bf_lo(gd.w)); v1[3] *= bf_hi(gn.w) * __builtin_amdgcn_rcpf(bf_hi(gd.w));
                    } else {
                        const u32x4 gn = *(const u32x4*)(gp + 2048);
                        u32x4 w; w.x = cvt_pk_bf16(v0[0] * bf_lo(gn.x), v0[1] * bf_hi(gn.x)); w.y = cvt_pk_bf16(v0[2] * bf_lo(gn.y), v0[3] * bf_hi(gn.y));
                        w.z = cvt_pk_bf16(v1[0] * bf_lo(gn.z), v1[1] * bf_hi(gn.z)); w.w = cvt_pk_bf16(v1[2] * bf_lo(gn.w), v1[3] * bf_hi(gn.w));
                        *(u32x4*)(merged + (size_t)row * DM + col) = w;
                    }
                }
            }
        return u.seg < 2;
    }
};
struct EpiOut {
    static constexpr bool PERM = false;
    const float* xres; float* X;
    DI bool operator()(f32x4 (&acc)[2][2][4][2], const Unit& u, int wr, int wc, int fr, int fq) const {
        const int row0 = u.pm * 256 + wr * 64 + fr;
#pragma unroll
        for (int ai = 0; ai < 2; ++ai)
#pragma unroll
            for (int m = 0; m < 4; ++m) {
                const size_t rb = (size_t)(row0 + ai * 128 + m * 16) * DM;
#pragma unroll
                for (int bj = 0; bj < 2; ++bj)
#pragma unroll
                    for (int n = 0; n < 2; ++n) {
                        const int col = u.pn * 256 + bj * 128 + wc * 32 + 16 * n + 4 * fq;
                        const f32x4 r = *(const f32x4*)(xres + rb + col);
                        *(f32x4*)(X + rb + col) = r * ALPHA + acc[ai][bj][m][n];
                    }
            }
        return false;
    }
};
struct EpiFfn {
    static constexpr bool PERM = true;
    bf16_t* hidden; bf16_t* pg;
    DI bool operator()(f32x4 (&acc)[2][2][4][2], const Unit& u, int wr, int wc, int fr, int fq) const {
        const int row0 = u.pm * 256 + wr * 64 + fr;
#pragma unroll
        for (int ai = 0; ai < 2; ++ai)
#pragma unroll
            for (int m = 0; m < 4; ++m) {
                const int row = row0 + ai * 128 + m * 16;
                if (u.pn < 22) {
                    const f32x4 g0 = acc[ai][0][m][0], g1 = acc[ai][0][m][1], u0 = acc[ai][1][m][0], u1 = acc[ai][1][m][1];
                    u32x4 w; w.x = cvt_pk_bf16(siluf_(g0[0]) * u0[0], siluf_(g0[1]) * u0[1]); w.y = cvt_pk_bf16(siluf_(g0[2]) * u0[2], siluf_(g0[3]) * u0[3]);
                    w.z = cvt_pk_bf16(siluf_(g1[0]) * u1[0], siluf_(g1[1]) * u1[1]); w.w = cvt_pk_bf16(siluf_(g1[2]) * u1[2], siluf_(g1[3]) * u1[3]);
                    *(u32x4*)(hidden + (size_t)row * HDW + u.pn * 128 + wc * 32 + 8 * fq) = w;
                } else {
#pragma unroll
                    for (int bj = 0; bj < 2; ++bj) {
                        const f32x4 v0 = acc[ai][bj][m][0], v1 = acc[ai][bj][m][1];
                        u32x4 w; w.x = cvt_pk_bf16(sigmoidf_(v0[0]), sigmoidf_(v0[1])); w.y = cvt_pk_bf16(sigmoidf_(v0[2]), sigmoidf_(v0[3]));
                        w.z = cvt_pk_bf16(sigmoidf_(v1[0]), sigmoidf_(v1[1])); w.w = cvt_pk_bf16(sigmoidf_(v1[2]), sigmoidf_(v1[3]));
                        *(u32x4*)(pg + (size_t)row * DM + (u.pn - 22) * 256 + bj * 128 + wc * 32 + 8 * fq) = w;
                    }
                }
            }
        return false;
    }
};
struct EpiDown {
    static constexpr bool PERM = false;
    const bf16_t* pg; float* X;
    DI bool operator()(f32x4 (&acc)[2][2][4][2], const Unit& u, int wr, int wc, int fr, int fq) const {
        const int row0 = u.pm * 256 + wr * 64 + fr;
#pragma unroll
        for (int ai = 0; ai < 2; ++ai)
#pragma unroll
            for (int m = 0; m < 4; ++m) {
                const size_t rb = (size_t)(row0 + ai * 128 + m * 16) * DM;
#pragma unroll
                for (int bj = 0; bj < 2; ++bj)
#pragma unroll
                    for (int n = 0; n < 2; ++n) {
                        const int col = u.pn * 256 + bj * 128 + wc * 32 + 16 * n + 4 * fq;
                        if (u.seg == 0) {
                            const u32x2 gq = *(const u32x2*)(pg + rb + col);
                            f32x4& v = acc[ai][bj][m][n];
                            v[0] *= bf_lo(gq.x); v[1] *= bf_hi(gq.x); v[2] *= bf_lo(gq.y); v[3] *= bf_hi(gq.y);
                        } else {
                            const f32x4 r = *(const f32x4*)(X + rb + col);
                            *(f32x4*)(X + rb + col) = r * ALPHA + acc[ai][bj][m][n];
                        }
                    }
            }
        return u.seg == 0;
    }
};

struct Args { const float* in[20]; float* out; unsigned char* ws; int ph_lo, ph_hi; };
enum { I_X = 0, I_P, I_WIN, I_POOLW, I_POOLS, I_WBA, I_WBB, I_WBC, I_LBL, I_HNW, I_WOUT, I_LN1G, I_LN1B, I_WFG, I_WFU, I_WFD, I_WPP, I_WPG, I_LN2G, I_LN2B };

struct Ctx {
    LAS unsigned char* lds; int tid, lane, wave, G, gw, NGW;
};

DI void tr_item(const float* W, int ld_src, int k0, int n0, bf16_t* dst, int ld_dst, int drow0, int dcol0, LAS float* scr, int lane) {
    f32x4 tv[8];
    const int lr = lane >> 3, lc = (lane & 7) * 4;
#pragma unroll
    for (int i = 0; i < 8; ++i) tv[i] = *(const f32x4*)(W + (size_t)(k0 + 8 * i + lr) * ld_src + n0 + lc);
#pragma unroll
    for (int i = 0; i < 8; ++i) { LAS float* d = scr + (8 * i + lr) * 33 + lc; d[0] = tv[i].x; d[1] = tv[i].y; d[2] = tv[i].z; d[3] = tv[i].w; }
    asm volatile("s_waitcnt lgkmcnt(0)" ::: "memory");
    const int c = lane & 7;
#pragma unroll
    for (int j = 0; j < 4; ++j) { const int n = (lane >> 3) + 8 * j; const LAS float* s = scr + (8 * c) * 33 + n;
        u32x4 o; o.x = cvt_pk_bf16(s[0 * 33], s[1 * 33]); o.y = cvt_pk_bf16(s[2 * 33], s[3 * 33]); o.z = cvt_pk_bf16(s[4 * 33], s[5 * 33]); o.w = cvt_pk_bf16(s[6 * 33], s[7 * 33]);
        *(u32x4*)(dst + (size_t)(drow0 + n) * ld_dst + dcol0 + 8 * c) = o; }
    asm volatile("s_waitcnt lgkmcnt(0)" ::: "memory");
}

DI void conv_weights(const Ctx& C, const Args& a, int z, int layer) {
    unsigned char* ws = a.ws + (size_t)z;
    LAS float* scr = (LAS float*)(C.lds + C.wave * 16384);
    bf16_t* WinT = (bf16_t*)(ws + WS_WIN); bf16_t* WcatT = (bf16_t*)(ws + WS_WCAT); bf16_t* WoutT = (bf16_t*)(ws + WS_WOUT); bf16_t* WguT = (bf16_t*)(ws + WS_WGU); bf16_t* WdpT = (bf16_t*)(ws + WS_WDP);
    const float* w_in = a.in[I_WIN + z] + (size_t)layer * DM * INW;
    const float* wbb = a.in[I_WBB + z] + (size_t)layer * 512 * DM; const float* wbc = a.in[I_WBC + z] + (size_t)layer * DM * DM; const float* wba = a.in[I_WBA + z] + (size_t)layer * DM * DM;
    const float* wout = a.in[I_WOUT + z] + (size_t)layer * DM * DM;
    const float* wfg = a.in[I_WFG + z] + (size_t)layer * DM * FFH; const float* wfu = a.in[I_WFU + z] + (size_t)layer * DM * FFH; const float* wfd = a.in[I_WFD + z] + (size_t)layer * FFH * DM;
    const float* wpp = a.in[I_WPP + z] + (size_t)layer * PLE * DM; const float* wpg = a.in[I_WPG + z] + (size_t)layer * DM * DM;
    const float* poolw = a.in[I_POOLW + z] + (size_t)layer * 4 * 256 * 256; const float* pools = a.in[I_POOLS + z] + (size_t)layer * DM;
    constexpr int N_IN = 16 * 432, N_BB = 8 * 32, N_BC = 16 * 32, N_OUT = 16 * 32, N_FG = 16 * 88, N_FU = 16 * 88, N_PG = 16 * 32, N_FD = 44 * 32, N_PP = 4 * 32, N_PA = 128 * 16;
    constexpr int NTOT = N_IN + N_BB + N_BC + N_OUT + N_FG + N_FU + N_PG + N_FD + N_PP + N_PA;
    for (int it = C.gw; it < NTOT; it += C.NGW) {
        int r = it;
        if (r < N_IN) { const int kb = r / 432, nb = r % 432; tr_item(w_in, INW, 64 * kb, 32 * nb, WinT, DM, 32 * nb, 64 * kb, scr, C.lane); continue; } r -= N_IN;
        if (r < N_BB) { const int kb = r / 32, nb = r % 32; tr_item(wbb, DM, 64 * kb, 32 * nb, WcatT, MCW, 32 * nb, 1024 + 64 * kb, scr, C.lane); continue; } r -= N_BB;
        if (r < N_BC) { const int kb = r / 32, nb = r % 32; tr_item(wbc, DM, 64 * kb, 32 * nb, WcatT, MCW, 32 * nb, 1536 + 64 * kb, scr, C.lane); continue; } r -= N_BC;
        if (r < N_OUT) { const int kb = r / 32, nb = r % 32; tr_item(wout, DM, 64 * kb, 32 * nb, WoutT, DM, 32 * nb, 64 * kb, scr, C.lane); continue; } r -= N_OUT;
        if (r < N_FG) { const int kb = r / 88, nb = r % 88, n0 = 32 * nb; tr_item(wfg, FFH, 64 * kb, n0, WguT, DM, 256 * (n0 >> 7) + (n0 & 127), 64 * kb, scr, C.lane); continue; } r -= N_FG;
        if (r < N_FU) { const int kb = r / 88, nb = r % 88, n0 = 32 * nb; tr_item(wfu, FFH, 64 * kb, n0, WguT, DM, 256 * (n0 >> 7) + 128 + (n0 & 127), 64 * kb, scr, C.lane); continue; } r -= N_FU;
        if (r < N_PG) { const int kb = r / 32, nb = r % 32; tr_item(wpg, DM, 64 * kb, 32 * nb, WguT, DM, 5632 + 32 * nb, 64 * kb, scr, C.lane); continue; } r -= N_PG;
        if (r < N_FD) { const int kb = r / 32, nb = r % 32; tr_item(wfd, DM, 64 * kb, 32 * nb, WdpT, HDW, 32 * nb, 64 * kb, scr, C.lane); continue; } r -= N_FD;
        if (r < N_PP) { const int kb = r / 32, nb = r % 32; tr_item(wpp, DM, 64 * kb, 32 * nb, WdpT, HDW, 32 * nb, FFH + 64 * kb, scr, C.lane); continue; } r -= N_PP;
        {
            const int ko = r >> 4, nb = r & 15, k0 = ko * 8, g = k0 >> 8, n = nb * 64 + C.lane;
            float acc8[8];
#pragma unroll
            for (int j = 0; j < 8; ++j) acc8[j] = 0.f;
            const float* pw = poolw + (size_t)g * 65536 + (size_t)(k0 & 255) * 256;
            {
                const int j = C.lane >> 3, cb = (C.lane & 7) * 32;
#pragma unroll
                for (int q = 0; q < 8; ++q) { const f32x4 pv = *(const f32x4*)(pw + j * 256 + cb + 4 * q), sv = *(const f32x4*)(pools + g * 256 + cb + 4 * q);
                    *(LAS f32x4*)(scr + j * 256 + cb + 4 * q) = pv * sv; }
                asm volatile("s_waitcnt lgkmcnt(0)" ::: "memory");
            }
#pragma unroll 1
            for (int c0 = 0; c0 < 256; c0 += 16) {
                float wa[16];
#pragma unroll
                for (int u = 0; u < 16; ++u) wa[u] = wba[(size_t)(g * 256 + c0 + u) * DM + n];
#pragma unroll
                for (int u4 = 0; u4 < 4; ++u4)
#pragma unroll
                    for (int j = 0; j < 8; ++j) { const f32x4 p4 = *(const LAS f32x4*)(scr + j * 256 + c0 + 4 * u4);
                        acc8[j] += p4[0] * wa[4 * u4] + p4[1] * wa[4 * u4 + 1] + p4[2] * wa[4 * u4 + 2] + p4[3] * wa[4 * u4 + 3]; }
            }
            asm volatile("s_waitcnt lgkmcnt(0)" ::: "memory");
            u32x4 o; o.x = cvt_pk_bf16(acc8[0], acc8[1]); o.y = cvt_pk_bf16(acc8[2], acc8[3]); o.z = cvt_pk_bf16(acc8[4], acc8[5]); o.w = cvt_pk_bf16(acc8[6], acc8[7]);
            *(u32x4*)(WcatT + (size_t)n * MCW + k0) = o;
        }
    }
}

template <int NR>
DI void ln_rows(float* xrow, bf16_t* orow, const float* g, const float* b, int lane) {
    f32x4 v[NR][4]; float s[NR];
#pragma unroll
    for (int r = 0; r < NR; ++r)
#pragma unroll
        for (int j = 0; j < 4; ++j) v[r][j] = *((const f32x4*)(xrow + (size_t)r * DM) + lane + 64 * j);
#pragma unroll
    for (int r = 0; r < NR; ++r) { s[r] = 0.f;
#pragma unroll
        for (int j = 0; j < 4; ++j) s[r] += (v[r][j].x + v[r][j].y) + (v[r][j].z + v[r][j].w); }
#pragma unroll
    for (int r = 0; r < NR; ++r) s[r] = wave_sum(s[r], lane) * (1.f / DM);
    float s2[NR];
#pragma unroll
    for (int r = 0; r < NR; ++r) { s2[r] = 0.f;
#pragma unroll
        for (int j = 0; j < 4; ++j) { v[r][j] = v[r][j] - s[r]; s2[r] += (v[r][j].x * v[r][j].x + v[r][j].y * v[r][j].y) + (v[r][j].z * v[r][j].z + v[r][j].w * v[r][j].w); } }
#pragma unroll
    for (int r = 0; r < NR; ++r) s2[r] = 1.f / sqrtf(wave_sum(s2[r], lane) * (1.f / DM) + LN_EPS);
#pragma unroll
    for (int j = 0; j < 4; ++j) {
        const f32x4 gg = *((const f32x4*)g + lane + 64 * j), bb = *((const f32x4*)b + lane + 64 * j);
#pragma unroll
        for (int r = 0; r < NR; ++r) {
            const f32x4 y = v[r][j] * s2[r] * gg + bb;
            *((f32x4*)(xrow + (size_t)r * DM) + lane + 64 * j) = y;
            u32x2 w; w.x = cvt_pk_bf16(y.x, y.y); w.y = cvt_pk_bf16(y.z, y.w); *((u32x2*)(orow + (size_t)r * DM) + lane + 64 * j) = w;
        }
    }
}

DI void pool_task(const Ctx& C, int wt, const bf16_t* projc, bf16_t* mixcat, int tok0) {
    const int tl = wt >> 1, c0 = (wt & 1) * 512 + C.lane * 8, g = c0 >> 8, half = 1 << g;
    const int t = tl % SEQ, base = tl - t;
    const int lo = (t - half) < 0 ? 0 : (t - half), hi = (t + half) > SEQ ? SEQ : (t + half);
    float s[8];
#pragma unroll
    for (int j = 0; j < 8; ++j) s[j] = 0.f;
    u32x4 pv[16];
#pragma unroll
    for (int q = 0; q < 16; ++q) { const int row = t - half + q; const bool ok = (q < 2 * half) && (row >= 0) && (row < SEQ);
        pv[q] = ok ? *(const u32x4*)(projc + (size_t)(base + row) * PJW + C_POOL + c0) : (u32x4){0u, 0u, 0u, 0u}; }
#pragma unroll
    for (int q = 0; q < 16; ++q) { const u32x4 v = pv[q];
        s[0] += bf_lo(v.x); s[1] += bf_hi(v.x); s[2] += bf_lo(v.y); s[3] += bf_hi(v.y); s[4] += bf_lo(v.z); s[5] += bf_hi(v.z); s[6] += bf_lo(v.w); s[7] += bf_hi(v.w); }
    const float inv = 1.f / (float)(hi - lo);
    const u32x4 v = *(const u32x4*)(projc + (size_t)tl * PJW + C_POOL + c0);
    u32x4 o; o.x = cvt_pk_bf16(s[0] * inv - bf_lo(v.x), s[1] * inv - bf_hi(v.x)); o.y = cvt_pk_bf16(s[2] * inv - bf_lo(v.y), s[3] * inv - bf_hi(v.y));
    o.z = cvt_pk_bf16(s[4] * inv - bf_lo(v.z), s[5] * inv - bf_hi(v.z)); o.w = cvt_pk_bf16(s[6] * inv - bf_lo(v.w), s[7] * inv - bf_hi(v.w));
    *(u32x4*)(mixcat + (size_t)(tok0 + tl) * MCW + c0) = o;
}

typedef float f32x16 __attribute__((ext_vector_type(16)));
#define MFMA32(a, b, c) __builtin_amdgcn_mfma_f32_32x32x16_bf16((a), (b), (c), 0, 0, 0)
constexpr int HG_QS = 272, HG_KTS = 80, HG_E1S = 528;
constexpr int HG_QE = 0, HG_KE = 8704, HG_KDT = 17408, HG_VV = 27648, HG_DEC = 29696, HG_E1 = 30208, HG_LDS = 47104;
DI bf16x8 pack8(const f32x16& x, int s) {
    u32x4 p; p.x = cvt_pk_bf16(x[8 * s], x[8 * s + 1]); p.y = cvt_pk_bf16(x[8 * s + 2], x[8 * s + 3]); p.z = cvt_pk_bf16(x[8 * s + 4], x[8 * s + 5]); p.w = cvt_pk_bf16(x[8 * s + 6], x[8 * s + 7]);
    return __builtin_bit_cast(bf16x8, p);
}
constexpr int HP_QE = 0, HP_KE = 8704, HP_KDT = 17408, HP_VV = 27648, HP_VS = 272, HP_LDS = 36352;
DI void hgrn_prep_task(const Ctx& C, int task, const bf16_t* projc, const float* logf, float* ohg, u32x4* QF, u32x4* KF, u32x4* VF, float* DCb, LAS unsigned char* L) {
    const int n = task & 127, h = (task >> 7) & 7, bl = task >> 10;
    const int lane = C.lane, r32 = lane & 31, hi = lane >> 5;
    const size_t rowb = (size_t)bl * SEQ + (size_t)n * 32;
    bf16x8 PA0, PA1, PB0, PB1;
    {
        const int s = lane >> 1, vh = (lane & 1) * 64; const bf16_t* src = projc + (rowb + s) * PJW + C_HI + h * 128 + vh;
#pragma unroll
        for (int hf = 0; hf < 2; ++hf) { u32x4 t[4];
#pragma unroll
            for (int i = 0; i < 4; ++i) t[i] = *(const u32x4*)(src + 8 * (4 * hf + i));
#pragma unroll
            for (int i = 0; i < 4; ++i) *(LAS u32x4*)(L + HP_VV + s * HP_VS + vh * 2 + (4 * hf + i) * 16) = t[i]; }
    }
#pragma unroll 1
    for (int dir = 0; dir < 2; ++dir) {
        const int item = (bl * 8 + h) * 2 + dir;
        const int cq = C_HQ + h * 128, ck = C_HFF + dir * 1024 + h * 128, cf = dir * 1024 + h * 128;
        {
            const int ep = 2 * lane;
            f32x2 bb[32]; unsigned kk[32];
#pragma unroll
            for (int s = 0; s < 32; ++s) { bb[s] = *(const f32x2*)(logf + (rowb + s) * 2048 + cf + ep); kk[s] = *(const unsigned*)(projc + (rowb + s) * PJW + ck + ep); }
            f32x2 be;
            if (dir == 0) {
#pragma unroll
                for (int s = 1; s < 32; ++s) bb[s] = bb[s] + bb[s - 1];
                be = bb[31];
            } else {
#pragma unroll
                for (int s = 30; s >= 0; --s) bb[s] = bb[s] + bb[s + 1];
                be = bb[0];
            }
#pragma unroll
            for (int s = 0; s < 32; ++s) *(LAS f32x2*)(L + s * HG_E1S + ep * 4) = bb[s];
            *(f32x2*)(DCb + ((size_t)item * 128 + n) * 256 + ep) = (f32x2){__expf(be.x), __expf(be.y)};
#pragma unroll
            for (int i = 0; i < 4; ++i) {
                u32x4 w0, w1;
#pragma unroll
                for (int j = 0; j < 4; ++j) { const int s0 = 8 * i + 2 * j;
                    w0[j] = cvt_pk_bf16(bf_lo(kk[s0]) * __expf(be.x - bb[s0].x), bf_lo(kk[s0 + 1]) * __expf(be.x - bb[s0 + 1].x));
                    w1[j] = cvt_pk_bf16(bf_hi(kk[s0]) * __expf(be.y - bb[s0].y), bf_hi(kk[s0 + 1]) * __expf(be.y - bb[s0 + 1].y)); }
                *(LAS u32x4*)(L + HP_KDT + ep * HG_KTS + i * 16) = w0; *(LAS u32x4*)(L + HP_KDT + (ep + 1) * HG_KTS + i * 16) = w1;
            }
        }
        asm volatile("s_waitcnt lgkmcnt(0)" ::: "memory");
        {
            const int s = lane >> 1, eh = (lane & 1) * 64;
            u32x4 qrow[8], krow_[8];
            { const bf16_t* qp = projc + (rowb + s) * PJW + cq + eh; const bf16_t* kp = projc + (rowb + s) * PJW + ck + eh;
#pragma unroll
              for (int i = 0; i < 8; ++i) { qrow[i] = *(const u32x4*)(qp + 8 * i); krow_[i] = *(const u32x4*)(kp + 8 * i); } }
            f32x4 bv[16];
#pragma unroll
            for (int i = 0; i < 16; ++i) bv[i] = *(const LAS f32x4*)(L + s * HG_E1S + (eh + 4 * i) * 4);
            asm volatile("s_waitcnt lgkmcnt(0)" ::: "memory");
#pragma unroll
            for (int i = 0; i < 8; ++i) {
                const u32x4 qv = qrow[i], kv = krow_[i];
                float e[8], ie[8];
#pragma unroll
                for (int j = 0; j < 4; ++j) { e[j] = __expf(fmaxf(bv[2 * i][j], -80.f)); e[4 + j] = __expf(fmaxf(bv[2 * i + 1][j], -80.f)); }
#pragma unroll
                for (int j = 0; j < 8; ++j) ie[j] = __builtin_amdgcn_rcpf(e[j]);
                u32x4 qo, ko;
                qo.x = cvt_pk_bf16(bf_lo(qv.x) * e[0], bf_hi(qv.x) * e[1]); qo.y = cvt_pk_bf16(bf_lo(qv.y) * e[2], bf_hi(qv.y) * e[3]);
                qo.z = cvt_pk_bf16(bf_lo(qv.z) * e[4], bf_hi(qv.z) * e[5]); qo.w = cvt_pk_bf16(bf_lo(qv.w) * e[6], bf_hi(qv.w) * e[7]);
                ko.x = cvt_pk_bf16(bf_lo(kv.x) * ie[0], bf_hi(kv.x) * ie[1]); ko.y = cvt_pk_bf16(bf_lo(kv.y) * ie[2], bf_hi(kv.y) * ie[3]);
                ko.z = cvt_pk_bf16(bf_lo(kv.z) * ie[4], bf_hi(kv.z) * ie[5]); ko.w = cvt_pk_bf16(bf_lo(kv.w) * ie[6], bf_hi(kv.w) * ie[7]);
                *(LAS u32x4*)(L + HP_QE + s * HG_QS + (eh + 8 * i) * 2) = qo; *(LAS u32x4*)(L + HP_KE + s * HG_QS + (eh + 8 * i) * 2) = ko;
            }
        }
        asm volatile("s_waitcnt lgkmcnt(0)" ::: "memory");
        {
            f32x16 at;
#pragma unroll
            for (int r = 0; r < 16; ++r) at[r] = 0.f;
#pragma unroll
            for (int ks = 0; ks < 8; ++ks) {
                const bf16x8 A = *(const LAS bf16x8*)(L + HP_KE + r32 * HG_QS + (ks * 16 + 8 * hi) * 2), B = *(const LAS bf16x8*)(L + HP_QE + r32 * HG_QS + (ks * 16 + 8 * hi) * 2);
                at = MFMA32(A, B, at);
            }
#pragma unroll
            for (int r = 0; r < 16; ++r) { const int srow = (r & 3) + 8 * (r >> 2) + 4 * hi; const bool keep = dir ? (srow >= r32) : (srow <= r32); at[r] = keep ? at[r] : 0.f; }
            if (dir == 0) { PA0 = pack8(at, 0); PA1 = pack8(at, 1); } else { PB0 = pack8(at, 0); PB1 = pack8(at, 1); }
        }
        {
            u32x4* qfp = QF + (((size_t)item * 128 + n) * 8) * 64 + lane; u32x4* kfp = KF + (((size_t)item * 128 + n) * 8) * 64 + lane;
#pragma unroll
            for (int b = 0; b < 4; ++b)
#pragma unroll
                for (int sp = 0; sp < 2; ++sp) {
                    const u32x2 a0 = *(const LAS u32x2*)(L + HP_QE + r32 * HG_QS + (b * 32 + 16 * sp + 4 * hi) * 2), a1 = *(const LAS u32x2*)(L + HP_QE + r32 * HG_QS + (b * 32 + 16 * sp + 8 + 4 * hi) * 2);
                    qfp[(b * 2 + sp) * 64] = (u32x4){a0.x, a0.y, a1.x, a1.y};
                    const u32x2 c0 = *(const LAS u32x2*)(L + HP_KDT + (b * 32 + r32) * HG_KTS + (16 * sp + 4 * hi) * 2), c1 = *(const LAS u32x2*)(L + HP_KDT + (b * 32 + r32) * HG_KTS + (16 * sp + 8 + 4 * hi) * 2);
                    kfp[(b * 2 + sp) * 64] = (u32x4){c0.x, c0.y, c1.x, c1.y};
                }
        }
        asm volatile("s_waitcnt lgkmcnt(0)" ::: "memory");
    }
#pragma unroll
    for (int vs = 0; vs < 4; ++vs) {
        bf16x8 v0, v1;
#pragma unroll
        for (int j = 0; j < 8; ++j) { v0[j] = (short)*(const LAS bf16_t*)(L + HP_VV + (8 * (j >> 2) + 4 * hi + (j & 3)) * HP_VS + (vs * 32 + r32) * 2);
                                      v1[j] = (short)*(const LAS bf16_t*)(L + HP_VV + (16 + 8 * (j >> 2) + 4 * hi + (j & 3)) * HP_VS + (vs * 32 + r32) * 2); }
        f32x16 o;
#pragma unroll
        for (int r = 0; r < 16; ++r) o[r] = 0.f;
        o = MFMA32(PA0, v0, o); o = MFMA32(PA1, v1, o); o = MFMA32(PB0, v0, o); o = MFMA32(PB1, v1, o);
        u32x4* vfp = VF + ((((size_t)(bl * 8 + h) * 128 + n) * 4 + vs) * 2) * 64 + lane; vfp[0] = __builtin_bit_cast(u32x4, v0); vfp[64] = __builtin_bit_cast(u32x4, v1);
#pragma unroll
        for (int r = 0; r < 16; ++r) { const int t = (r & 3) + 8 * (r >> 2) + 4 * hi; ohg[(rowb + t) * DM + h * 128 + vs * 32 + r32] = o[r]; }
    }
    asm volatile("s_waitcnt lgkmcnt(0)" ::: "memory");
}

constexpr int HS_SLOT = 19456, HS_NSLOT = 4, HS_ORING = HS_NSLOT * HS_SLOT, HS_DSR = HS_ORING + 2 * 4096, HS_CTL = HS_DSR + 2 * 16384, HS_END = HS_CTL + 512;
DI unsigned lds_poll(LAS unsigned char* p) { return *(volatile LAS unsigned*)p; }
DI void hgrn_scan_role(const Ctx& C, int role, int ht, const u32x4* QF, const u32x4* KF, const u32x4* VF, const float* DCb, float* ohg, float* OIF0, float* OIF1, LAS unsigned char* L) {
    const int vs = ht & 3, dir = (ht >> 2) & 1, h = (ht >> 3) & 7, bl = ht >> 6;
    const int lane = C.lane, r32 = lane & 31, hi = lane >> 5;
    const int item = (bl * 8 + h) * 2 + dir, bh = bl * 8 + h;
    LAS unsigned char* w_ready = L + HS_CTL; LAS unsigned char* w_cons = L + HS_CTL + 64; LAS unsigned char* w_oready = L + HS_CTL + 128; LAS unsigned char* w_ofree = L + HS_CTL + 192;
    LAS unsigned char* w_dsready = L + HS_CTL + 256; LAS unsigned char* w_dsfree = L + HS_CTL + 320; LAS unsigned char* w_cons2 = L + HS_CTL + 384;
    if (role == 1) {
        int seen = 0;
        for (int j = 0; j < 128; ++j) {
            if (seen + HS_NSLOT <= j) { for (;;) { const int c0 = (int)lds_poll(w_cons), c1 = (int)lds_poll(w_cons2); seen = c0 < c1 ? c0 : c1; if (seen + HS_NSLOT > j) break; __builtin_amdgcn_s_sleep(1); } }
            const int n_ = dir ? 127 - j : j; const int slot_ = (j & (HS_NSLOT - 1)) * HS_SLOT;
            const u32x4* q_ = QF + (((size_t)item * 128 + n_) * 8) * 64 + lane; const u32x4* k_ = KF + (((size_t)item * 128 + n_) * 8) * 64 + lane;
            const u32x4* v_ = VF + ((((size_t)bh * 128 + n_) * 4 + vs) * 2) * 64 + lane; const u32x4* d_ = (const u32x4*)(DCb + ((size_t)item * 128 + n_) * 256) + lane;
#pragma unroll
            for (int f = 0; f < 8; ++f) __builtin_amdgcn_global_load_lds((const unsigned*)(q_ + f * 64), (LAS unsigned*)(L + slot_ + f * 1024), 16, 0, 0);
#pragma unroll
            for (int f = 0; f < 8; ++f) __builtin_amdgcn_global_load_lds((const unsigned*)(k_ + f * 64), (LAS unsigned*)(L + slot_ + 8192 + f * 1024), 16, 0, 0);
#pragma unroll
            for (int f = 0; f < 2; ++f) __builtin_amdgcn_global_load_lds((const unsigned*)(v_ + f * 64), (LAS unsigned*)(L + slot_ + 16384 + f * 1024), 16, 0, 0);
            __builtin_amdgcn_global_load_lds((const unsigned*)d_, (LAS unsigned*)(L + slot_ + 18432), 16, 0, 0);
            if (j >= 2) { asm volatile("s_waitcnt vmcnt(38)" ::: "memory"); *(volatile LAS unsigned*)w_ready = (unsigned)(j - 1); }
        }
        asm volatile("s_waitcnt vmcnt(19)" ::: "memory"); *(volatile LAS unsigned*)w_ready = 127u;
        asm volatile("s_waitcnt vmcnt(0)" ::: "memory"); *(volatile LAS unsigned*)w_ready = 128u;
        asm volatile("s_waitcnt lgkmcnt(0)" ::: "memory");
    } else if (role == 3) {
        int seen_ready = 0, seen_free = 0;
        for (int j = 0; j < 128; ++j) {
            const int slot = (j & (HS_NSLOT - 1)) * HS_SLOT;
            if (seen_ready <= j) { while ((seen_ready = (int)lds_poll(w_ready)) <= j) __builtin_amdgcn_s_sleep(1); }
            const bf16x8 vf0 = *(const LAS bf16x8*)(L + slot + 16384 + lane * 16), vf1 = *(const LAS bf16x8*)(L + slot + 17408 + lane * 16);
            bf16x8 kfr[8];
#pragma unroll
            for (int f = 0; f < 8; ++f) kfr[f] = *(const LAS bf16x8*)(L + slot + 8192 + f * 1024 + lane * 16);
            __builtin_amdgcn_sched_barrier(0);
            asm volatile("s_waitcnt lgkmcnt(0)" ::: "memory");
            __builtin_amdgcn_sched_barrier(0);
            f32x16 d4[4];
#pragma unroll
            for (int b = 0; b < 4; ++b)
#pragma unroll
                for (int r = 0; r < 16; ++r) d4[b][r] = 0.f;
#pragma unroll
            for (int b = 0; b < 4; ++b) d4[b] = MFMA32(kfr[b * 2], vf0, d4[b]);
#pragma unroll
            for (int b = 0; b < 4; ++b) d4[b] = MFMA32(kfr[b * 2 + 1], vf1, d4[b]);
            *(volatile LAS unsigned*)w_cons2 = (unsigned)(j + 1);
            if (seen_free + 2 <= j) { while ((seen_free = (int)lds_poll(w_dsfree)) + 2 <= j) __builtin_amdgcn_s_sleep(1); }
            LAS f32x4* dd = (LAS f32x4*)(L + HS_DSR + (j & 1) * 16384) + lane;
#pragma unroll
            for (int b = 0; b < 4; ++b)
#pragma unroll
                for (int g4 = 0; g4 < 4; ++g4) dd[(b * 4 + g4) * 64] = (f32x4){d4[b][4 * g4], d4[b][4 * g4 + 1], d4[b][4 * g4 + 2], d4[b][4 * g4 + 3]};
            asm volatile("s_waitcnt lgkmcnt(0)" ::: "memory");
            *(volatile LAS unsigned*)w_dsready = (unsigned)(j + 1);
        }
        asm volatile("s_waitcnt lgkmcnt(0)" ::: "memory");
    } else if (role == 0) {
        f32x16 S[4];
#pragma unroll
        for (int b = 0; b < 4; ++b)
#pragma unroll
            for (int r = 0; r < 16; ++r) S[b][r] = 0.f;
        int seen_ready = 0, seen_ds = 0, seen_ofree = 0;
        for (int i = 0; i < 128; ++i) {
            const int slot = (i & (HS_NSLOT - 1)) * HS_SLOT;
            if (seen_ready <= i) { while ((seen_ready = (int)lds_poll(w_ready)) <= i) __builtin_amdgcn_s_sleep(1); }
            bf16x8 qf[8];
#pragma unroll
            for (int f = 0; f < 8; ++f) qf[f] = *(const LAS bf16x8*)(L + slot + f * 1024 + lane * 16);
            __builtin_amdgcn_sched_barrier(0);
            asm volatile("s_waitcnt lgkmcnt(0)" ::: "memory");
            __builtin_amdgcn_sched_barrier(0);
            f32x16 o, o2;
#pragma unroll
            for (int r = 0; r < 16; ++r) { o[r] = 0.f; o2[r] = 0.f; }
#pragma unroll
            for (int b = 0; b < 4; ++b) {
                o = MFMA32(qf[b * 2], pack8(S[b], 0), o);
                o2 = MFMA32(qf[b * 2 + 1], pack8(S[b], 1), o2);
            }
            if (seen_ds <= i) { while ((seen_ds = (int)lds_poll(w_dsready)) <= i) __builtin_amdgcn_s_sleep(1); }
            const LAS f32x4* dd = (const LAS f32x4*)(L + HS_DSR + (i & 1) * 16384) + lane;
#pragma unroll
            for (int hb = 0; hb < 2; ++hb) {
                f32x4 dk[8], dx[8];
#pragma unroll
                for (int q = 0; q < 8; ++q) { const int b = hb * 2 + (q >> 2), g4 = q & 3;
                    dk[q] = *(const LAS f32x4*)(L + slot + 18432 + (b * 32 + 8 * g4 + 4 * hi) * 4); dx[q] = dd[(b * 4 + g4) * 64]; }
                __builtin_amdgcn_sched_barrier(0);
                asm volatile("s_waitcnt lgkmcnt(0)" ::: "memory");
                __builtin_amdgcn_sched_barrier(0);
#pragma unroll
                for (int q = 0; q < 8; ++q) { const int b = hb * 2 + (q >> 2), g4 = q & 3; const f32x4 d = dk[q], x = dx[q];
                    S[b][4 * g4] = S[b][4 * g4] * d[0] + x[0]; S[b][4 * g4 + 1] = S[b][4 * g4 + 1] * d[1] + x[1]; S[b][4 * g4 + 2] = S[b][4 * g4 + 2] * d[2] + x[2]; S[b][4 * g4 + 3] = S[b][4 * g4 + 3] * d[3] + x[3]; }
            }
            *(volatile LAS unsigned*)w_cons = (unsigned)(i + 1);
            *(volatile LAS unsigned*)w_dsfree = (unsigned)(i + 1);
            if (seen_ofree + 2 <= i) { while ((seen_ofree = (int)lds_poll(w_ofree)) + 2 <= i) __builtin_amdgcn_s_sleep(1); }
            LAS f32x4* od = (LAS f32x4*)(L + HS_ORING + (i & 1) * 4096) + lane;
#pragma unroll
            for (int q = 0; q < 4; ++q) od[q * 64] = (f32x4){o[4 * q] + o2[4 * q], o[4 * q + 1] + o2[4 * q + 1], o[4 * q + 2] + o2[4 * q + 2], o[4 * q + 3] + o2[4 * q + 3]};
            asm volatile("s_waitcnt lgkmcnt(0)" ::: "memory");
            *(volatile LAS unsigned*)w_oready = (unsigned)(i + 1);
        }
        asm volatile("s_waitcnt lgkmcnt(0)" ::: "memory");
    } else {
        int seen = 0;
        for (int i = 0; i < 128; ++i) {
            if (seen <= i) { while ((seen = (int)lds_poll(w_oready)) <= i) __builtin_amdgcn_s_sleep(1); }
            const LAS f32x4* od = (const LAS f32x4*)(L + HS_ORING + (i & 1) * 4096) + lane;
            float o[16];
#pragma unroll
            for (int q = 0; q < 4; ++q) { const f32x4 v = od[q * 64]; o[4 * q] = v[0]; o[4 * q + 1] = v[1]; o[4 * q + 2] = v[2]; o[4 * q + 3] = v[3]; }
            asm volatile("s_waitcnt lgkmcnt(0)" ::: "memory");
            *(volatile LAS unsigned*)w_ofree = (unsigned)(i + 1);
            const int n = dir ? 127 - i : i; const size_t rowb = (size_t)bl * SEQ + (size_t)n * 32;
            if (dir == 0) {
                float* pl = (bl ? OIF1 : OIF0) + ((size_t)n * 32) * DM + h * 128 + vs * 32 + r32;
#pragma unroll
                for (int r = 0; r < 16; ++r) { const int t = (r & 3) + 8 * (r >> 2) + 4 * hi; pl[(size_t)t * DM] = o[r]; }
            } else {
#pragma unroll
                for (int r = 0; r < 16; ++r) { const int t = (r & 3) + 8 * (r >> 2) + 4 * hi; unsafeAtomicAdd(ohg + (rowb + t) * DM + h * 128 + vs * 32 + r32, o[r]); }
            }
        }
        asm volatile("s_waitcnt vmcnt(0) lgkmcnt(0)" ::: "memory");
    }
}

constexpr int AT_VS = 288, AT_LDS = 32 * AT_VS;
DI void attn_mfma_task(const Ctx& C, int task, const bf16_t* projc, bf16_t* attO, float* lse, LAS unsigned char* L) {
    const int lane = C.lane, r32 = lane & 31, hi = lane >> 5;
    const int tb = task & 127, h = (task >> 7) % 12, bl = task / (128 * 12);
    const int g = h >> 2, dsh = (g == 0) ? 0 : (g == 1 ? 2 : 4);
    const int Lc = SEQ >> dsh, bpc = Lc >> 5;
    const int rc = tb / bpc, i0 = (tb % bpc) * 32;
    const size_t base = (size_t)bl * SEQ;
    const float slope_d = exp2f(-8.0f * (float)(h + 1) / 12.0f) * (float)(1 << dsh);
    const bf16_t* qrow = projc + (base + (size_t)(((i0 + r32) << dsh) + rc)) * PJW + C_AQ + h * 128 + 8 * hi;
    bf16x8 qf[8];
#pragma unroll
    for (int ks = 0; ks < 8; ++ks) qf[ks] = *(const bf16x8*)(qrow + ks * 16);
    f32x16 sc[5];
    bf16x8 kf[8], kn[8];
#define AT_KLOAD(dst, kt_) do { int zz_; asm volatile("v_mov_b32 %0, 0" : "=v"(zz_)); int ik_ = i0 - 64 + 32 * (kt_) + r32 + zz_; ik_ = ik_ < 0 ? 0 : (ik_ > Lc - 1 ? Lc - 1 : ik_); \
        const bf16_t* kr_ = projc + (base + (size_t)((ik_ << dsh) + rc)) * PJW + C_AK + h * 128 + 8 * hi; \
        _Pragma("unroll") for (int ks = 0; ks < 8; ++ks) dst[ks] = *(const bf16x8*)(kr_ + ks * 16); } while (0)
    AT_KLOAD(kf, 0);
#pragma unroll
    for (int kt = 0; kt < 5; ++kt) {
        int zk; asm volatile("v_mov_b32 %0, 0" : "=v"(zk));
        if (kt < 4) AT_KLOAD(kn, kt + 1);
        f32x16 a;
#pragma unroll
        for (int r = 0; r < 16; ++r) a[r] = 0.f;
#pragma unroll
        for (int ks = 0; ks < 8; ++ks) a = MFMA32(kf[ks], qf[ks], a);
#pragma unroll
        for (int r = 0; r < 16; ++r) {
            const int kk = 32 * kt - 64 + (r & 3) + 8 * (r >> 2) + 4 * hi + zk, off = kk - r32, ki = i0 + kk;
            const bool valid = (off >= -64) && (off <= 64) && (ki >= 0) && (ki < Lc);
            a[r] = valid ? a[r] - slope_d * (float)(off < 0 ? -off : off) : -1e30f;
        }
        sc[kt] = a;
        if (kt < 4) {
#pragma unroll
            for (int ks = 0; ks < 8; ++ks) kf[ks] = kn[ks];
        }
    }
#undef AT_KLOAD
    float m = -1e30f;
#pragma unroll
    for (int kt = 0; kt < 5; ++kt)
#pragma unroll
        for (int r = 0; r < 16; ++r) m = fmaxf(m, sc[kt][r]);
    m = fmaxf(m, sh32(m, lane));
    float l = 0.f;
#pragma unroll
    for (int kt = 0; kt < 5; ++kt)
#pragma unroll
        for (int r = 0; r < 16; ++r) { sc[kt][r] = __expf(sc[kt][r] - m); l += sc[kt][r]; }
    l += sh32(l, lane);
    const float il = 1.f / l;
#pragma unroll
    for (int kt = 0; kt < 5; ++kt)
#pragma unroll
        for (int r = 0; r < 16; ++r) sc[kt][r] *= il;
    if (hi == 0) lse[(base + (size_t)(((i0 + r32) << dsh) + rc)) * 12 + h] = m + __logf(l);
    f32x16 o[4];
#pragma unroll
    for (int b = 0; b < 4; ++b)
#pragma unroll
        for (int r = 0; r < 16; ++r) o[b][r] = 0.f;
    u32x4 tv[8];
    const int vrow = lane >> 1, vhalf = lane & 1;
#define AT_VLOAD(kt_) do { int zz_; asm volatile("v_mov_b32 %0, 0" : "=v"(zz_)); int ik_ = i0 - 64 + 32 * (kt_) + vrow + zz_; ik_ = ik_ < 0 ? 0 : (ik_ > Lc - 1 ? Lc - 1 : ik_); \
        const bf16_t* vs_ = projc + (base + (size_t)((ik_ << dsh) + rc)) * PJW + C_AV + h * 128 + vhalf * 64; \
        _Pragma("unroll") for (int i = 0; i < 8; ++i) tv[i] = *(const u32x4*)(vs_ + 8 * i); } while (0)
    AT_VLOAD(0);
#pragma unroll
    for (int kt = 0; kt < 5; ++kt) {
#pragma unroll
        for (int i = 0; i < 8; ++i) *(LAS u32x4*)(L + vrow * AT_VS + vhalf * 128 + i * 16) = tv[i];
        if (kt < 4) AT_VLOAD(kt + 1);
        asm volatile("s_waitcnt lgkmcnt(0)" ::: "memory");
#pragma unroll
        for (int sp = 0; sp < 2; ++sp) {
            const bf16x8 A = pack8(sc[kt], sp);
#pragma unroll
            for (int b = 0; b < 4; ++b) {
                bf16x8 B;
#pragma unroll
                for (int j = 0; j < 8; ++j) B[j] = (short)*(const LAS bf16_t*)(L + (16 * sp + 8 * (j >> 2) + 4 * hi + (j & 3)) * AT_VS + (b * 32 + r32) * 2);
                o[b] = MFMA32(A, B, o[b]);
            }
        }
        asm volatile("s_waitcnt lgkmcnt(0)" ::: "memory");
    }
#undef AT_VLOAD
#pragma unroll
    for (int r = 0; r < 16; ++r) {
        const int qi = i0 + (r & 3) + 8 * (r >> 2) + 4 * hi;
        bf16_t* dst = attO + (base + (size_t)((qi << dsh) + rc)) * 1536 + h * 128 + r32;
#pragma unroll
        for (int b = 0; b < 4; ++b) dst[b * 32] = (bf16_t)(cvt_pk_bf16(o[b][r], 0.f) & 0xffffu);
    }
}

DI void fin_task(const Ctx& C, int tl, const float* hnw, const float* OIF0, const float* OIF1, const float* ohg, bf16_t* mixcat, int tok0, const bf16_t* attO, const float* lse) {
    const int lane = C.lane, hh = lane >> 3, v0 = (lane & 7) * 16;
    {
        const int j = lane >> 4, dv0 = (lane & 15) * 8;
        const float l0 = lse[(size_t)tl * 12 + j], l1 = lse[(size_t)tl * 12 + 4 + j], l2 = lse[(size_t)tl * 12 + 8 + j];
        const float mx = fmaxf(l0, fmaxf(l1, l2)); float w0 = __expf(l0 - mx), w1 = __expf(l1 - mx), w2 = __expf(l2 - mx); const float iw = 1.f / (w0 + w1 + w2); w0 *= iw; w1 *= iw; w2 *= iw;
        const bf16_t* ap = attO + (size_t)tl * 1536 + j * 128 + dv0;
        const u32x4 a = *(const u32x4*)ap, b = *(const u32x4*)(ap + 512), c = *(const u32x4*)(ap + 1024);
        u32x4 w;
        w.x = cvt_pk_bf16(w0 * bf_lo(a.x) + w1 * bf_lo(b.x) + w2 * bf_lo(c.x), w0 * bf_hi(a.x) + w1 * bf_hi(b.x) + w2 * bf_hi(c.x));
        w.y = cvt_pk_bf16(w0 * bf_lo(a.y) + w1 * bf_lo(b.y) + w2 * bf_lo(c.y), w0 * bf_hi(a.y) + w1 * bf_hi(b.y) + w2 * bf_hi(c.y));
        w.z = cvt_pk_bf16(w0 * bf_lo(a.z) + w1 * bf_lo(b.z) + w2 * bf_lo(c.z), w0 * bf_hi(a.z) + w1 * bf_hi(b.z) + w2 * bf_hi(c.z));
        w.w = cvt_pk_bf16(w0 * bf_lo(a.w) + w1 * bf_lo(b.w) + w2 * bf_lo(c.w), w0 * bf_hi(a.w) + w1 * bf_hi(b.w) + w2 * bf_hi(c.w));
        *(u32x4*)(mixcat + (size_t)(tok0 + tl) * MCW + 1024 + j * 128 + dv0) = w;
    }
    const float* op = ohg + (size_t)tl * DM + hh * 128 + v0;
    f32x4 o[4]; float ss = 0.f;
    const float* fp = (tl >= SEQ ? OIF1 + (size_t)(tl - SEQ) * DM : OIF0 + (size_t)tl * DM) + hh * 128 + v0;
#pragma unroll
    for (int i = 0; i < 4; ++i) { o[i] = *(const f32x4*)(op + 4 * i) + *(const f32x4*)(fp + 4 * i); ss += o[i].x * o[i].x + o[i].y * o[i].y + o[i].z * o[i].z + o[i].w * o[i].w; }
    ss += SHX(ss, 1); ss += SHX(ss, 2); ss += SHX(ss, 4);
    const float rstd = 1.f / sqrtf(ss * (1.f / 128.f) + RMS_EPS);
    const float* nw = hnw + hh * 128 + v0;
    bf16_t* dst = mixcat + (size_t)(tok0 + tl) * MCW + 1536 + hh * 128 + v0;
    const bf16_t* gp = dst;
#pragma unroll
    for (int i = 0; i < 2; ++i) {
        const u32x4 gv = *(const u32x4*)(gp + 8 * i); const f32x4 n0 = *(const f32x4*)(nw + 8 * i), n1 = *(const f32x4*)(nw + 8 * i + 4);
        const f32x4 a = o[2 * i], b = o[2 * i + 1];
        u32x4 w; w.x = cvt_pk_bf16(a.x * rstd * n0.x * bf_lo(gv.x), a.y * rstd * n0.y * bf_hi(gv.x)); w.y = cvt_pk_bf16(a.z * rstd * n0.z * bf_lo(gv.y), a.w * rstd * n0.w * bf_hi(gv.y));
        w.z = cvt_pk_bf16(b.x * rstd * n1.x * bf_lo(gv.z), b.y * rstd * n1.y * bf_hi(gv.z)); w.w = cvt_pk_bf16(b.z * rstd * n1.z * bf_lo(gv.w), b.w * rstd * n1.w * bf_hi(gv.w));
        *(u32x4*)(dst + 8 * i) = w;
    }
}

#define XB_TMO      128
#define XB_XCNT(j)  (256  + 64 * (j))
#define XB_XSUB(j)  (1280 + 64 * (j))
#define XB_XGEN(j)  (2304 + 64 * (j))
#define XB_TOP      3328
#define XB_TOPGEN   3392
#define XCD_BAR_WORDS 3456
#define XB_SPIN_CAP (1u << 22)
DI unsigned xb_ld(unsigned* p)              { return __hip_atomic_load(p, __ATOMIC_RELAXED, __HIP_MEMORY_SCOPE_AGENT); }
DI unsigned xb_add(unsigned* p, unsigned v) { return __hip_atomic_fetch_add(p, v, __ATOMIC_RELAXED, __HIP_MEMORY_SCOPE_AGENT); }
DI unsigned xb_xcc_id() { return (unsigned)__builtin_amdgcn_s_getreg((3 << 11) | 20) & 0xFu; }
#define XB_SPIN(cond, bar) do { unsigned _sp = 0; while (cond) { __builtin_amdgcn_s_sleep(1); \
    if ((++_sp & 255u) == 0u) { if (xb_ld(&(bar)[XB_TMO])) break; if (_sp > XB_SPIN_CAP) { atomicAdd(&(bar)[XB_TMO], 1u); break; } } } } while (0)
DI void xcd_barrier_complete(unsigned* bar, unsigned x, unsigned& nloc, unsigned& nx) {
    const unsigned G = gridDim.x * gridDim.y * gridDim.z;
    unsigned sum, cnt, mine, sp = 0u;
    for (;;) {
        sum = 0u; cnt = 0u; mine = 0u;
#pragma unroll
        for (unsigned j = 0; j < 16; ++j) { const unsigned c = xb_ld(&bar[XB_XCNT(j)]); sum += c; cnt += (c > 0u) ? 1u : 0u; mine = (j == x) ? c : mine; }
        if (sum == G) break;
        __builtin_amdgcn_s_sleep(1);
        if ((++sp & 255u) == 0u) { if (xb_ld(&bar[XB_TMO])) break; if (sp > XB_SPIN_CAP) { atomicAdd(&bar[XB_TMO], 1u); break; } }
    }
    nloc = mine > 0u ? mine : 1u; nx = cnt > 0u ? cnt : 1u;
}
DI void xcd_barrier(unsigned* bar, unsigned x, volatile LAS unsigned* st, bool is_t0) {
    asm volatile("s_waitcnt vmcnt(0)" ::: "memory");
    __syncthreads();
    if (is_t0) {
        __builtin_amdgcn_s_waitcnt(0);
        unsigned nloc = st[0], nx = st[1];
        if (nloc == 0u) { xcd_barrier_complete(bar, x, nloc, nx); st[0] = nloc; st[1] = nx; }
        const unsigned old = xb_add(&bar[XB_XSUB(x)], 1u);
        const unsigned gen = old / nloc;
        if (old + 1u == (gen + 1u) * nloc) {
            __builtin_amdgcn_fence(__ATOMIC_RELEASE, "agent");
            asm volatile("s_waitcnt vmcnt(0)" ::: "memory");
            const unsigned og = xb_add(&bar[XB_TOP], 1u);
            const unsigned tg = og / nx;
            if (og + 1u == (tg + 1u) * nx) xb_add(&bar[XB_TOPGEN], 1u);
            else XB_SPIN(xb_ld(&bar[XB_TOPGEN]) == tg, bar);
            __builtin_amdgcn_fence(__ATOMIC_ACQUIRE, "agent");
            xb_add(&bar[XB_XGEN(x)], 1u);
            asm volatile("s_waitcnt vmcnt(0)" ::: "memory");
        } else {
            XB_SPIN(xb_ld(&bar[XB_XGEN(x)]) == gen, bar);
            __builtin_amdgcn_fence(__ATOMIC_ACQUIRE, "agent");
            asm volatile("s_waitcnt vmcnt(0)" ::: "memory");
        }
    }
    __syncthreads();
}

constexpr int NMIX = 3 * NCH + 1;
constexpr int PH_PER_LAYER = NMIX + 6, NPH = 1 + DEPTH * PH_PER_LAYER;

__global__ void __launch_bounds__(512, 2) mega(Args args) {
    extern __shared__ __attribute__((aligned(16))) unsigned char lds_raw[];
    cg::grid_group grid = cg::this_grid();
    const int wave_s = __builtin_amdgcn_readfirstlane(threadIdx.x >> 6);
    volatile LAS unsigned* xb_st = (volatile LAS unsigned*)((LAS unsigned char*)lds_raw + LDS_BYTES - 64);
    unsigned* xb_bar = (unsigned*)(args.ws + WS_BAR);
    const unsigned xb_x = xb_xcc_id();
    const bool xb_t0 = (threadIdx.x == 0);
    if (xb_t0) { xb_st[0] = 0u; xb_st[1] = 0u; (void)xb_add(&xb_bar[XB_XCNT(xb_x)], 1u); }
    __syncthreads();
    for (int ph = args.ph_lo; ph < args.ph_hi; ++ph) {
        if (ph > args.ph_lo) {
            asm volatile("s_waitcnt vmcnt(0) lgkmcnt(0)" ::: "memory");
            if (ph == args.ph_lo + 1) {
                grid.sync();
                if (wave_s == 0) { __builtin_amdgcn_fence(__ATOMIC_ACQUIRE, "agent"); asm volatile("s_waitcnt vmcnt(0)" ::: "memory"); }
                __builtin_amdgcn_s_barrier(); asm volatile("" ::: "memory");
            } else xcd_barrier(xb_bar, xb_x, xb_st, xb_t0);
        }
        int z, zv; asm volatile("s_mov_b32 %0, 0" : "=s"(z)); asm volatile("v_mov_b32 %0, 0" : "=v"(zv));
        Ctx C; C.lds = (LAS unsigned char*)lds_raw; { int ln; asm volatile("v_mbcnt_lo_u32_b32 %0, -1, 0\n\tv_mbcnt_hi_u32_b32 %0, -1, %0" : "=&v"(ln)); C.lane = ln; } C.wave = wave_s + z; C.tid = C.wave * 64 + C.lane;
        const int bid = blockIdx.x + z; const float fz = __int_as_float(zv);
        C.G = gridDim.x + z; C.gw = bid * 8 + C.wave; C.NGW = C.G * 8;
        unsigned char* ws = args.ws + (size_t)z;
        float* lbv = (float*)(ws + WS_LB);
        bf16_t* WinT = (bf16_t*)(ws + WS_WIN); bf16_t* WcatT = (bf16_t*)(ws + WS_WCAT); bf16_t* WoutT = (bf16_t*)(ws + WS_WOUT); bf16_t* WguT = (bf16_t*)(ws + WS_WGU); bf16_t* WdpT = (bf16_t*)(ws + WS_WDP);
        bf16_t* Xbf = (bf16_t*)(ws + WS_XBF); bf16_t* mixcat = (bf16_t*)(ws + WS_MIXCAT); bf16_t* gates = (bf16_t*)(ws + WS_GATES); bf16_t* projc = (bf16_t*)(ws + WS_PROJC);
        float* logf = (float*)(ws + WS_LOGF); float* ohg = (float*)(ws + WS_OHG); bf16_t* merged = (bf16_t*)(ws + WS_MERGED); bf16_t* hidden = (bf16_t*)(ws + WS_HIDDEN); bf16_t* pgb = (bf16_t*)(ws + WS_PG); bf16_t* attO = (bf16_t*)(ws + WS_ATTO); float* lsev = (float*)(ws + WS_LSE);
        float* OIF1 = (float*)(ws + WS_OIF1); u32x4* QF = (u32x4*)(ws + WS_QF); u32x4* KF = (u32x4*)(ws + WS_KF); u32x4* VF = (u32x4*)(ws + WS_VF); float* DCb = (float*)(ws + WS_DC);
        float* X = args.out;

        if (ph == 0) {
            for (int jx = bid * 512 + C.tid; jx < 2048; jx += C.G * 512) {
                const float* L = args.in[I_LBL + z];
                const float x0 = L[jx], x1 = L[2048 + jx], x2 = L[4096 + jx], x3 = L[6144 + jx];
                const float mx = fmaxf(fmaxf(x0, x1), fmaxf(x2, x3));
                const float e0 = expf(x0 - mx), e1 = expf(x1 - mx), e2 = expf(x2 - mx), e3 = expf(x3 - mx), inv = 1.f / (e0 + e1 + e2 + e3);
                lbv[jx] = 0.f; lbv[2048 + jx] = e1 * inv; lbv[4096 + jx] = (e1 + e2) * inv; lbv[6144 + jx] = (e1 + e2 + e3) * inv;
            }
            conv_weights(C, args, z, 0);
            const float* x = args.in[I_X + z];
            {
                const size_t stride = (size_t)C.G * 512, nitem = (size_t)T * DM / 8;
                size_t i = (size_t)bid * 512 + C.tid;
                for (; i + 3 * stride < nitem; i += 4 * stride) {
                    f32x4 a[4], b[4];
#pragma unroll
                    for (int q = 0; q < 4; ++q) { a[q] = *(const f32x4*)(x + (i + q * stride) * 8); b[q] = *(const f32x4*)(x + (i + q * stride) * 8 + 4); }
#pragma unroll
                    for (int q = 0; q < 4; ++q) { u32x4 w; w.x = cvt_pk_bf16(a[q].x, a[q].y); w.y = cvt_pk_bf16(a[q].z, a[q].w); w.z = cvt_pk_bf16(b[q].x, b[q].y); w.w = cvt_pk_bf16(b[q].z, b[q].w);
                        *(u32x4*)(Xbf + (i + q * stride) * 8) = w; }
                }
                for (; i < nitem; i += stride) {
                    const f32x4 a = *(const f32x4*)(x + i * 8), b = *(const f32x4*)(x + i * 8 + 4);
                    u32x4 w; w.x = cvt_pk_bf16(a.x, a.y); w.y = cvt_pk_bf16(a.z, a.w); w.z = cvt_pk_bf16(b.x, b.y); w.w = cvt_pk_bf16(b.z, b.w);
                    *(u32x4*)(Xbf + i * 8) = w;
                }
            }
            continue;
        }
        const int layer = (ph - 1) / PH_PER_LAYER, r = (ph - 1) % PH_PER_LAYER;
        if (r < NMIX) {
            const int ch = r < 3 * NCH ? r / 3 : NCH - 1, sub = r < 3 * NCH ? r % 3 : 3, tok0 = ch * TC;
            if (sub == 0) {
                if (ch > 0) { const float* hnw = args.in[I_HNW + z] + (size_t)layer * DM;
                    for (int tl = C.gw; tl < TC; tl += C.NGW) fin_task(C, tl, hnw, (const float*)Xbf, OIF1, ohg, mixcat, tok0 - TC, attO, lsev); }
                pg8::Gemm g{Xbf + (size_t)tok0 * DM, WinT, DM, DM};
                typedef pg8::SegSched<1, 0, 0, 0, 16, 16, 16> SS; SS S; S.o.init(TC / 256, INW / 256, C.G, bid);
                EpiProj E{projc, logf, gates, lbv + layer * 2048, tok0, mixcat};
                pg8::gemm_phase<EpiProj, SS>(C.lds, C.tid, fz, g, S, E);
            } else if (sub == 1) {
                if (C.wave < 4) {
                    LAS unsigned char* scr = C.lds + C.wave * HP_LDS;
                    for (int t = bid * 4 + C.wave; t < 2 * 8 * 128; t += C.G * 4) hgrn_prep_task(C, t, projc, logf, ohg, QF, KF, VF, DCb, scr);
                } else {
                    for (int wt = bid * 4 + (C.wave - 4); wt < TC * 2; wt += C.G * 4) pool_task(C, wt, projc, mixcat, tok0);
                }
            } else if (sub == 2) {
                if (C.tid < 8) *(volatile LAS unsigned*)(C.lds + HS_CTL + 64 * C.tid) = 0u;
                asm volatile("s_waitcnt lgkmcnt(0)" ::: "memory"); __builtin_amdgcn_s_barrier(); asm volatile("" ::: "memory");
                const bool scan_wg = bid < 128;
                if (scan_wg && C.wave < 4) hgrn_scan_role(C, C.wave, bid, QF, KF, VF, DCb, ohg, (float*)Xbf, OIF1, C.lds);
                else if (!scan_wg) {
                    const int nscan = C.G < 128 ? C.G : 128;
                    LAS unsigned char* scr = C.lds + C.wave * 10240;
                    const int w = (bid - nscan) * 8 + C.wave, nw = (C.G - nscan) * 8;
                    for (int wt = w; wt < 2 * 12 * 128; wt += nw) attn_mfma_task(C, wt, projc, attO, lsev, scr);
                }
            } else {
                const float* hnw = args.in[I_HNW + z] + (size_t)layer * DM;
                for (int tl = C.gw; tl < TC; tl += C.NGW) fin_task(C, tl, hnw, (const float*)Xbf, OIF1, ohg, mixcat, tok0, attO, lsev);
            }
        } else if (r == NMIX) {
            pg8::Gemm g{mixcat, WcatT, MCW, MCW};
            typedef pg8::SegSched<3, 0, 1024, 1536, 16, 8, 16> SS; SS S; S.o.init(T / 256, DM / 256, C.G, bid);
            EpiMerge E{gates, merged};
            pg8::gemm_phase<EpiMerge, SS>(C.lds, C.tid, fz, g, S, E);
        } else if (r == NMIX + 1) {
            pg8::Gemm g{merged, WoutT, DM, DM};
            typedef pg8::SegSched<1, 0, 0, 0, 16, 16, 16> SS; SS S; S.o.init(T / 256, DM / 256, C.G, bid);
            EpiOut E{layer == 0 ? args.in[I_X + z] : (const float*)X, X};
            pg8::gemm_phase<EpiOut, SS>(C.lds, C.tid, fz, g, S, E);
        } else if (r == NMIX + 2) {
            const float* g1 = args.in[I_LN1G + z] + layer * DM; const float* b1 = args.in[I_LN1B + z] + layer * DM;
            const float* p = args.in[I_P + z] + (size_t)layer * T * PLE;
            for (int row = C.gw * 4; row < T; row += C.NGW * 4) {
                ln_rows<4>(X + (size_t)row * DM, Xbf + (size_t)row * DM, g1, b1, C.lane);
#pragma unroll
                for (int q = 0; q < 4; ++q) {
                    const f32x4 pv = *((const f32x4*)(p + (size_t)(row + q) * PLE) + C.lane);
                    u32x2 w; w.x = cvt_pk_bf16(pv.x, pv.y); w.y = cvt_pk_bf16(pv.z, pv.w);
                    *((u32x2*)(hidden + (size_t)(row + q) * HDW + FFH) + C.lane) = w;
                }
            }
        } else if (r == NMIX + 3) {
            pg8::Gemm g{Xbf, WguT, DM, DM};
            typedef pg8::SegSched<1, 0, 0, 0, 16, 16, 16> SS; SS S; S.o.init(T / 256, 6656 / 256, C.G, bid);
            EpiFfn E{hidden, pgb};
            pg8::gemm_phase<EpiFfn, SS>(C.lds, C.tid, fz, g, S, E);
        } else if (r == NMIX + 4) {
            pg8::Gemm g{hidden, WdpT, HDW, HDW};
            typedef pg8::SegSched<2, FFH, 0, 0, 4, 44, 44> SS; SS S; S.o.init(T / 256, DM / 256, C.G, bid);
            EpiDown E{pgb, X};
            pg8::gemm_phase<EpiDown, SS>(C.lds, C.tid, fz, g, S, E);
        } else {
            const float* g2 = args.in[I_LN2G + z] + layer * DM; const float* b2 = args.in[I_LN2B + z] + layer * DM;
            for (int row = C.gw * 4; row < T; row += C.NGW * 4) ln_rows<4>(X + (size_t)row * DM, Xbf + (size_t)row * DM, g2, b2, C.lane);
            if (layer + 1 < DEPTH) conv_weights(C, args, z, layer + 1);
        }
    }
}

extern "C" void kernel_launch(void* const* d_in, const int* in_sizes, int n_in, void* d_out, int out_size, void* d_ws, size_t ws_size, hipStream_t stream) {
    static int grid = 0;
    if (grid == 0) {
        if (n_in != 20 || out_size != T * DM || ws_size < WS_END) { fprintf(stderr, "kernel_launch: unexpected problem (n_in %d out %d ws %zu)\n", n_in, out_size, ws_size); grid = -1; return; }
        int dev = 0, cus = 0, per_cu = 0;
        hipGetDevice(&dev); hipDeviceGetAttribute(&cus, hipDeviceAttributeMultiprocessorCount, dev);
        hipFuncSetAttribute((const void*)mega, hipFuncAttributeMaxDynamicSharedMemorySize, LDS_BYTES);
        hipOccupancyMaxActiveBlocksPerMultiprocessor(&per_cu, (const void*)mega, 512, LDS_BYTES);
        if (per_cu < 1) { fprintf(stderr, "kernel_launch: occupancy query says %d\n", per_cu); per_cu = 1; }
        (void)hipGetLastError();
        grid = cus * 1;
    }
    if (grid < 0) return;
    (void)hipMemsetAsync((char*)d_ws + WS_BAR, 0, XCD_BAR_WORDS * 4, stream);
    Args a{};
    for (int i = 0; i < 20; ++i) a.in[i] = (const float*)d_in[i];
    a.out = (float*)d_out; a.ws = (unsigned char*)d_ws;
#if MK_MULTI
    for (int ph = 0; ph < NPH; ++ph) { a.ph_lo = ph; a.ph_hi = ph + 1; void* kargs[] = {&a};
        hipError_t e = hipLaunchCooperativeKernel((const void*)mega, dim3(grid), dim3(512), kargs, LDS_BYTES, stream);
        if (e != hipSuccess) { fprintf(stderr, "launch %d failed: %s\n", ph, hipGetErrorString(e)); break; } }
#else
    a.ph_lo = 0; a.ph_hi = NPH; void* kargs[] = {&a};
    hipError_t e = hipLaunchCooperativeKernel((const void*)mega, dim3(grid), dim3(512), kargs, LDS_BYTES, stream);
    if (e != hipSuccess) fprintf(stderr, "cooperative launch failed: %s (grid %d)\n", hipGetErrorString(e), grid);
#endif
}
```
